# Optimizing an MI355X kernel written in HIP

```python
import math
import jax, jax.numpy as jnp
from jax import lax
import numpy as np

D_MODEL = 1024
BATCH = 2
SEQ = 8192
DEPTH = 4

D_MIX = D_MODEL
POOL_WINDOWS = (2, 4, 8, 16)
POOL_GROUPS = len(POOL_WINDOWS)
POOL_CH = 64
POOL_WIDTH = POOL_GROUPS * POOL_CH
MAX_WIN = max(POOL_WINDOWS)
HGRN_WIDTH = D_MIX - POOL_WIDTH
HGRN_HEAD_DIM = 128
HGRN_HEADS = HGRN_WIDTH // HGRN_HEAD_DIM
CHUNK = 64
D_FF = 4 * D_MODEL
RMS_EPS = 1e-5
IN_WIDTH = POOL_WIDTH + 4 * HGRN_WIDTH

kernel_name = "hymba_pool_hgrn2_hybrid"


def rms_norm(x, g, eps=RMS_EPS):
    xf = x.astype(jnp.float32)
    y = xf * lax.rsqrt(jnp.mean(xf * xf, axis=-1, keepdims=True) + eps)
    return (y * g.astype(jnp.float32)).astype(x.dtype)


def pool_mixer(u, w, scale):
    B, S, _ = u.shape
    uf = u.astype(jnp.float32)
    c = jnp.cumsum(uf, axis=1)
    cp = jnp.pad(c, ((0, 0), (MAX_WIN, 0), (0, 0)))
    t = jnp.arange(S)
    groups = []
    for gi, win in enumerate(POOL_WINDOWS):
        lo, hi = gi * POOL_CH, (gi + 1) * POOL_CH
        win_sum = c[:, :, lo:hi] - cp[:, MAX_WIN - win:MAX_WIN - win + S, lo:hi]
        cnt = jnp.minimum(t + 1, win).astype(jnp.float32)[None, :, None]
        groups.append(win_sum / cnt - uf[:, :, lo:hi])
    p = jnp.stack(groups, axis=2)
    y = jnp.einsum('bsgc,gcd->bsgd', p, w.astype(jnp.float32)).reshape(B, S, POOL_WIDTH)
    return (y * scale.astype(jnp.float32)).astype(u.dtype)


def _to_chunks(t, B, S):
    return t.reshape(B, S // CHUNK, CHUNK, HGRN_HEADS, HGRN_HEAD_DIM).transpose(1, 0, 3, 2, 4)


def hgrn2_mixer(q_raw, f_raw, i_raw, g_raw, lb, norm_g):
    B, S, _ = q_raw.shape
    z = f_raw.astype(jnp.float32)
    lbf = lb.astype(jnp.float32)
    log_f = jnp.logaddexp(jnp.log(lbf), jnp.log1p(-lbf) + jax.nn.log_sigmoid(z))
    k = (1.0 - lbf) * jax.nn.sigmoid(-z)
    q = jax.nn.silu(q_raw.astype(jnp.float32))
    v = i_raw.astype(jnp.float32)
    qc, kc, vc, fc = (_to_chunks(a, B, S) for a in (q, k, v, log_f))
    causal = jnp.tril(jnp.ones((CHUNK, CHUNK), dtype=bool))[None, None, :, :, None]

    def chunk_step(state, inp):
        qb, kb, vb, lfb = inp
        b = jnp.cumsum(lfb, axis=2)
        diff = jnp.where(causal, b[:, :, :, None, :] - b[:, :, None, :, :], -jnp.inf)
        scores = jnp.einsum('bhtk,bhsk,bhtsk->bhts', qb, kb, jnp.exp(diff))
        o = (jnp.einsum('bhts,bhsv->bhtv', scores, vb)
             + jnp.einsum('bhtk,bhkv->bhtv', qb * jnp.exp(b), state))
        b_last = b[:, :, -1:, :]
        new_state = (jnp.exp(b_last[:, :, 0, :])[..., None] * state
                     + jnp.einsum('bhsk,bhsv->bhkv', kb * jnp.exp(b_last - b), vb))
        return new_state, o

    s0 = jnp.zeros((B, HGRN_HEADS, HGRN_HEAD_DIM, HGRN_HEAD_DIM), jnp.float32)
    _, o = lax.scan(chunk_step, s0, (qc, kc, vc, fc))
    o = o.transpose(1, 0, 3, 2, 4).reshape(B, S, HGRN_HEADS, HGRN_HEAD_DIM)
    o = o * lax.rsqrt(jnp.mean(o * o, axis=-1, keepdims=True) + RMS_EPS)
    o = o.reshape(B, S, HGRN_WIDTH) * norm_g.astype(jnp.float32)
    o = o * jax.nn.silu(g_raw.astype(jnp.float32))
    return o.astype(q_raw.dtype)


def setup_inputs(seed: int = 0) -> dict:
    key = jax.random.key(seed)
    ks = jax.random.split(key, 12)
    f32 = jnp.float32
    x = jax.random.normal(ks[0], (BATCH, SEQ, D_MODEL), f32)
    norm_mix_g = 1.0 + 0.05 * jax.random.normal(ks[1], (DEPTH, D_MODEL), f32)
    w_in = jax.random.normal(ks[2], (DEPTH, D_MODEL, IN_WIDTH), f32) * D_MODEL ** -0.5
    pool_w = jax.random.normal(ks[3], (DEPTH, POOL_GROUPS, POOL_CH, POOL_CH), f32) * POOL_CH ** -0.5
    pool_scale = 1.0 + 0.1 * jax.random.normal(ks[4], (DEPTH, POOL_WIDTH), f32)
    hgrn_lb_logits = 0.5 * jax.random.normal(ks[5], (DEPTH, HGRN_WIDTH), f32)
    hgrn_norm_g = 1.0 + 0.05 * jax.random.normal(ks[6], (DEPTH, HGRN_WIDTH), f32)
    w_out = jax.random.normal(ks[7], (DEPTH, D_MIX, D_MODEL), f32) * D_MIX ** -0.5
    norm_mlp_g = 1.0 + 0.05 * jax.random.normal(ks[8], (DEPTH, D_MODEL), f32)
    w_up = jax.random.normal(ks[9], (DEPTH, D_MODEL, D_FF), f32) * D_MODEL ** -0.5
    w_down = jax.random.normal(ks[10], (DEPTH, D_FF, D_MODEL), f32) * D_FF ** -0.5
    final_norm_g = 1.0 + 0.05 * jax.random.normal(ks[11], (D_MODEL,), f32)
    return {"x": x, "norm_mix_g": norm_mix_g, "w_in": w_in, "pool_w": pool_w,
            "pool_scale": pool_scale, "hgrn_lb_logits": hgrn_lb_logits,
            "hgrn_norm_g": hgrn_norm_g, "w_out": w_out, "norm_mlp_g": norm_mlp_g,
            "w_up": w_up, "w_down": w_down, "final_norm_g": final_norm_g}


def reference(x, norm_mix_g, w_in, pool_w, pool_scale, hgrn_lb_logits, hgrn_norm_g,
              w_out, norm_mlp_g, w_up, w_down, final_norm_g):
    lb_cum = jnp.cumsum(jax.nn.softmax(hgrn_lb_logits.astype(jnp.float32), axis=0), axis=0)
    lower_bounds = lb_cum - lb_cum[0:1]
    splits = [POOL_WIDTH + j * HGRN_WIDTH for j in range(4)]
    for l in range(DEPTH):
        h = rms_norm(x, norm_mix_g[l])
        u = h @ w_in[l]
        u_pool, q_raw, f_raw, i_raw, g_raw = jnp.split(u, splits, axis=-1)
        y_pool = pool_mixer(u_pool, pool_w[l], pool_scale[l])
        y_hgrn = hgrn2_mixer(q_raw, f_raw, i_raw, g_raw, lower_bounds[l], hgrn_norm_g[l])
        x = x + jnp.concatenate([y_pool, y_hgrn], axis=-1) @ w_out[l]
        h2 = rms_norm(x, norm_mlp_g[l])
        x = x + jnp.square(jax.nn.relu(h2 @ w_up[l])) @ w_down[l]
    return rms_norm(x, final_norm_g)
```

```cpp
#include <hip/hip_runtime.h>
#include <hip/hip_cooperative_groups.h>
#include <cstdio>
#include <cstdint>
namespace cg = cooperative_groups;
namespace pg8 {
#define PG8_LAS __attribute__((address_space(3)))
typedef unsigned short bf16_t;
typedef short bf16x8 __attribute__((ext_vector_type(8)));
typedef float f32x4 __attribute__((ext_vector_type(4)));
typedef unsigned u32x4 __attribute__((ext_vector_type(4)));
constexpr int BM = 256, BK = 64, HALF = 128, HTB = HALF * BK * 2  , STAGE_BYTES = 8 * HTB, NXCD = 8, WGM = 8;

__host__ __device__ __forceinline__ int lds_byte(int r, int c) { const int st = (r >> 4) * 2 + (c >> 5), rr = r & 15, cc = c & 31, ob = rr * 64 + cc * 2; return st * 1024 + (ob ^ (((ob >> 9) & 1) << 5)); }
__host__ __device__ __forceinline__ void stage_rc(int b, int& R, int& C) { const int st = b / 1024, sb = b % 1024, swz = sb ^ (((sb >> 9) & 1) << 5); R = (st >> 1) * 16 + swz / 64; C = (st & 1) * 32 + (swz % 64) / 2; }
__host__ __device__ __forceinline__ int perm32(int rho) { const int n = rho >> 4, i = rho & 15; return 8 * (i >> 2) + 4 * n + (i & 3); }

struct Unit { int pm, pn; };
struct Gemm { const bf16_t* A; const bf16_t* Bt; int M, N, K; };

struct StaticOrder {
    int nM, nN, nwg, G, c;
    __host__ __device__ void init(int M, int N, int G_, int c_) { nM = M / BM; nN = N / BM; nwg = nM * nN; G = G_; c = c_; }
    __host__ __device__ bool next(int i, Unit& u) const {
        const long L = (long)i * G + c; if (L >= nwg) return false;
        int wgid = (int)L; { const int q = nwg / NXCD, r = nwg % NXCD, xcd = wgid % NXCD, off = wgid / NXCD; wgid = (xcd < r ? xcd * (q + 1) : r * (q + 1) + (xcd - r) * q) + off; }
        const int nig = WGM * nN, gid = wgid / nig, fm = gid * WGM, gsz = (nM - fm) < WGM ? (nM - fm) : WGM;
        u.pm = fm + ((wgid % nig) % gsz); u.pn = (wgid % nig) / gsz; return true;
    }
    __device__ __forceinline__ void a_ready(const Unit&) const {}
    __device__ __forceinline__ void done(const Unit&) const {}
};

__device__ __forceinline__ unsigned cvt_pk_bf16(float lo, float hi) { unsigned r; asm volatile("v_cvt_pk_bf16_f32 %0, %1, %2" : "=v"(r) : "v"(lo), "v"(hi)); return r; }
typedef float f32x2 __attribute__((ext_vector_type(2)));

typedef unsigned u32x2 __attribute__((ext_vector_type(2)));
__device__ __forceinline__ float fast_rcp(float x) { return __builtin_amdgcn_rcpf(x); }
__device__ __forceinline__ float silu_f(float v) { return v * fast_rcp(1.0f + __expf(-v)); }
struct EpiAct {
    static constexpr bool PERM = true, AFTER_DRAIN = false;
    bf16_t* O; int ldc; const float* ss; const float* lb; int is_in;
    __device__ __forceinline__ void operator()(const f32x4 (&acc)[2][2][4][2], const Unit& u, int wr, int wc, int fr, int fq) const {
        const int row0 = u.pm * BM + wr * 64 + fr; const int col0 = u.pn * BM + wc * 32 + 8 * fq;
        int mode = 3;
        if (is_in) { const int t = u.pn; mode = (t == 0) ? 0 : (t <= 3 ? 1 : (t <= 6 ? 2 : (t <= 9 ? 0 : 1))); }
#pragma unroll
        for (int ai = 0; ai < 2; ++ai)
#pragma unroll
            for (int m = 0; m < 4; ++m) { const int r = row0 + ai * HALF + m * 16; const f32x4* sp = (const f32x4*)(ss + (size_t)r * 16); const f32x4 s0 = sp[0], s1 = sp[1], s2 = sp[2], s3 = sp[3];
                const float rs = rsqrtf((((s0[0] + s0[1]) + (s0[2] + s0[3])) + ((s1[0] + s1[1]) + (s1[2] + s1[3])) + (((s2[0] + s2[1]) + (s2[2] + s2[3])) + ((s3[0] + s3[1]) + (s3[2] + s3[3])))) * (1.0f / 1024.0f) + 1e-5f);
                bf16_t* rowp = O + (size_t)r * ldc + col0;
#pragma unroll
                for (int bj = 0; bj < 2; ++bj) { f32x4 v[2]; v[0] = acc[ai][bj][m][0] * rs; v[1] = acc[ai][bj][m][1] * rs;
                    if (mode == 1) {
#pragma unroll
                        for (int n = 0; n < 2; ++n)
#pragma unroll
                            for (int e = 0; e < 4; ++e) v[n][e] = silu_f(v[n][e]);
                    } else if (mode == 2) {
#pragma unroll
                        for (int n = 0; n < 2; ++n)
                            { const f32x4 lv = *(const f32x4*)(lb + (col0 - 1024) + bj * HALF + 4 * n);
#pragma unroll
                            for (int e = 0; e < 4; ++e) { const float s = fast_rcp(1.0f + __expf(-v[n][e])); const float l = lv[e]; v[n][e] = __logf(l + (1.0f - l) * s); } }
                    } else if (mode == 3) {
#pragma unroll
                        for (int n = 0; n < 2; ++n)
#pragma unroll
                            for (int e = 0; e < 4; ++e) { const float t = fmaxf(v[n][e], 0.f); v[n][e] = t * t; }
                    }
                    u32x4 w; w.x = cvt_pk_bf16(v[0][0], v[0][1]); w.y = cvt_pk_bf16(v[0][2], v[0][3]); w.z = cvt_pk_bf16(v[1][0], v[1][1]); w.w = cvt_pk_bf16(v[1][2], v[1][3]);
                    *(u32x4*)(rowp + bj * HALF) = w; }
                asm volatile("" ::: "memory"); }
    }
};
struct EpiResid {
    static constexpr bool PERM = false, AFTER_DRAIN = false;
    float* X; bf16_t* XB; float* ss;
    __device__ __forceinline__ void operator()(const f32x4 (&acc)[2][2][4][2], const Unit& u, int wr, int wc, int fr, int fq) const {
        const int col0 = u.pn * BM + wc * 32 + 4 * fq;
#pragma unroll
        for (int ai = 0; ai < 2; ++ai)
#pragma unroll
            for (int m = 0; m < 4; ++m) { const int r = u.pm * BM + ai * HALF + wr * 64 + m * 16 + fr; const size_t off = (size_t)r * 1024 + col0; float sq = 0.f;
#pragma unroll
                for (int bj = 0; bj < 2; ++bj)
#pragma unroll
                    for (int n = 0; n < 2; ++n) { float* p = X + off + bj * HALF + n * 16; const f32x4 o = *(const f32x4*)p + acc[ai][bj][m][n]; *(f32x4*)p = o;
                        sq += (o[0] * o[0] + o[1] * o[1]) + (o[2] * o[2] + o[3] * o[3]);
                        u32x2 w; w.x = cvt_pk_bf16(o[0], o[1]); w.y = cvt_pk_bf16(o[2], o[3]); *(u32x2*)(XB + off + bj * HALF + n * 16) = w; }
                sq += __shfl_xor(sq, 16); sq += __shfl_xor(sq, 32);
                if (fq == 0) ss[(size_t)r * 16 + u.pn * 4 + wc] = sq;
                asm volatile("" ::: "memory"); }
    }
};

template <class Epi, class Sched, bool ALIGN_EPI = false, bool SP2 = false>
__device__ __forceinline__ void gemm_phase(PG8_LAS unsigned char* lds, const Gemm g, const Sched& S, const Epi& E) {
    int tid_ = threadIdx.x; asm volatile("" : "+v"(tid_));
    const int tid = tid_, wid = __builtin_amdgcn_readfirstlane(tid >> 6), lane = tid & 63, wr = wid >> 2, wc = wid & 3, fr = lane & 15, fq = lane >> 4;
    const int K = g.K, nt = K / BK;
    unsigned voffA[2], voffB[2];
#pragma unroll
    for (int i = 0; i < 2; ++i) { int R, C; stage_rc(tid * 16 + i * 8192, R, C); const int Rb = Epi::PERM ? ((R & ~31) + perm32(R & 31)) : R;
        voffA[i] = (unsigned)(R * K + C) * 2u; voffB[i] = (unsigned)(Rb * K + C) * 2u; }
    const size_t kstep = (size_t)(BK * 2);
    const size_t hstep = (size_t)HALF * K * 2;
    const size_t tstep = 2 * hstep;
    const unsigned ldsw = (unsigned)wid * 1024u;
    const int aoff = lds_byte(wr * 64 + fr, fq * 8), boff = lds_byte(wc * 32 + fr, fq * 8);
#define PG8_SA(b, h) (((b) * 2 + (h)) * HTB)
#define PG8_SB(b, h) ((4 + (b) * 2 + (h)) * HTB)
#define PG8_STAGE(bufoff, gbase, voff) do { _Pragma("unroll") for (int _i = 0; _i < 2; ++_i) \
        __builtin_amdgcn_global_load_lds((const unsigned*)((const char*)(gbase) + (voff)[_i]), (PG8_LAS unsigned*)(lds + (bufoff) + ldsw + _i * 8192), 16, 0, 0); } while (0)
#define PG8_LDA(dst, b, h) do { _Pragma("unroll") for (int m = 0; m < 4; ++m) _Pragma("unroll") for (int k = 0; k < 2; ++k) dst[m][k] = *(const PG8_LAS bf16x8*)(lds + PG8_SA(b, h) + aoff + m * 2048 + k * 1024); } while (0)
#define PG8_LDB(dst, b, h) do { _Pragma("unroll") for (int n = 0; n < 2; ++n) _Pragma("unroll") for (int k = 0; k < 2; ++k) dst[n][k] = *(const PG8_LAS bf16x8*)(lds + PG8_SB(b, h) + boff + n * 2048 + k * 1024); } while (0)
#define PG8_MMA(ai, bj, At, Bt) do { __builtin_amdgcn_s_setprio(1); _Pragma("unroll") for (int m = 0; m < 4; ++m) _Pragma("unroll") for (int n = 0; n < 2; ++n) _Pragma("unroll") for (int k = 0; k < 2; ++k) \
        acc[ai][bj][m][n] = __builtin_amdgcn_mfma_f32_16x16x32_bf16(Bt[n][k], At[m][k], acc[ai][bj][m][n], 0, 0, 0); __builtin_amdgcn_s_setprio(0); } while (0)
#define PG8_WAIT_V(n) asm volatile("s_waitcnt vmcnt(" #n ")" ::: "memory")
#define PG8_WAIT_L(n) asm volatile("s_waitcnt lgkmcnt(" #n ")" ::: "memory")
#define PG8_BAR __builtin_amdgcn_s_barrier()
#define PG8_SCHED __builtin_amdgcn_sched_barrier(0)
    Unit cur, nxt; int ui = 0;
    if (!S.next(0, cur)) return;
    f32x4 acc[2][2][4][2];
#pragma unroll
    for (int a = 0; a < 2; ++a)
#pragma unroll
        for (int b = 0; b < 2; ++b)
#pragma unroll
            for (int m = 0; m < 4; ++m)
#pragma unroll
                for (int n = 0; n < 2; ++n) acc[a][b][m][n] = (f32x4){0.f, 0.f, 0.f, 0.f};
    bf16x8 At[4][2], B0[2][2], B1[2][2];
    const char* cA = (const char*)g.A + (size_t)cur.pm * tstep; const char* cB = (const char*)g.Bt + (size_t)cur.pn * tstep;
    S.a_ready(cur);
    if constexpr (SP2) {
        PG8_STAGE(PG8_SB(0, 0), cB, voffB); PG8_STAGE(PG8_SB(0, 1), cB + hstep, voffB); PG8_STAGE(PG8_SA(0, 0), cA, voffA); PG8_STAGE(PG8_SA(0, 1), cA + hstep, voffA);
        if (wr == 1) PG8_BAR;
        PG8_WAIT_V(2); PG8_BAR;
        PG8_STAGE(PG8_SB(1, 0), cB + kstep, voffB); PG8_STAGE(PG8_SA(1, 0), cA + kstep, voffA); PG8_STAGE(PG8_SB(1, 1), cB + hstep + kstep, voffB);
        PG8_WAIT_V(6); PG8_BAR;
    } else {
        PG8_STAGE(PG8_SB(0, 0), cB, voffB); PG8_STAGE(PG8_SA(0, 0), cA, voffA); PG8_STAGE(PG8_SB(0, 1), cB + hstep, voffB); PG8_STAGE(PG8_SA(0, 1), cA + hstep, voffA);
        if (wr == 1) PG8_BAR;
        PG8_WAIT_V(4); PG8_BAR;
        PG8_STAGE(PG8_SB(1, 0), cB + kstep, voffB); PG8_STAGE(PG8_SA(1, 0), cA + kstep, voffA); PG8_STAGE(PG8_SB(1, 1), cB + hstep + kstep, voffB);
        PG8_WAIT_V(6); PG8_BAR;
    }
    for (;;) {
        const bool has_next = S.next(ui + 1, nxt);
        const char* nA = has_next ? (const char*)g.A + (size_t)nxt.pm * tstep : cA; const char* nB = has_next ? (const char*)g.Bt + (size_t)nxt.pn * tstep : cB;
        for (int t = 0; t < nt; t += 2) {
            const bool last = (t == nt - 2);
            const char* a1 = cA + (size_t)(t + 1) * kstep;
            const char* a2 = last ? nA : cA + (size_t)(t + 2) * kstep; const char* b2 = last ? nB : cB + (size_t)(t + 2) * kstep;
            const char* a3 = a2 + kstep; const char* b3 = b2 + kstep;
            if (last && has_next) S.a_ready(nxt);
            if constexpr (SP2) {
            PG8_LDB(B0, 0, 0); PG8_LDB(B1, 0, 1); PG8_SCHED; PG8_LDA(At, 0, 0); PG8_STAGE(PG8_SA(1, 1), a1 + hstep, voffA);
            PG8_WAIT_V(8); PG8_WAIT_L(0); PG8_BAR; PG8_MMA(0, 0, At, B0); PG8_MMA(0, 1, At, B1); PG8_BAR; PG8_SCHED;
            PG8_LDA(At, 0, 1); PG8_STAGE(PG8_SB(0, 0), b2, voffB); PG8_STAGE(PG8_SB(0, 1), b2 + hstep, voffB); PG8_STAGE(PG8_SA(0, 0), a2, voffA);
            PG8_WAIT_V(8); PG8_WAIT_L(0); PG8_BAR; PG8_MMA(1, 0, At, B0); PG8_MMA(1, 1, At, B1); PG8_BAR; PG8_SCHED;
            PG8_LDB(B0, 1, 0); PG8_LDB(B1, 1, 1); PG8_SCHED; PG8_LDA(At, 1, 0); PG8_STAGE(PG8_SA(0, 1), a2 + hstep, voffA);
            PG8_WAIT_V(8); PG8_WAIT_L(0); PG8_BAR; PG8_MMA(0, 0, At, B0); PG8_MMA(0, 1, At, B1); PG8_BAR; PG8_SCHED;
            PG8_LDA(At, 1, 1); PG8_STAGE(PG8_SB(1, 0), b3, voffB); PG8_STAGE(PG8_SB(1, 1), b3 + hstep, voffB); PG8_STAGE(PG8_SA(1, 0), a3, voffA);
            PG8_WAIT_V(8); PG8_WAIT_L(0); PG8_BAR; PG8_MMA(1, 0, At, B0); PG8_MMA(1, 1, At, B1); PG8_BAR; PG8_SCHED;
            } else {
            PG8_LDB(B0, 0, 0); PG8_SCHED; PG8_LDA(At, 0, 0); PG8_STAGE(PG8_SA(1, 1), a1 + hstep, voffA);
            PG8_WAIT_L(8); PG8_BAR; PG8_WAIT_L(0); PG8_MMA(0, 0, At, B0); PG8_BAR; PG8_SCHED;
            PG8_LDB(B1, 0, 1); PG8_STAGE(PG8_SB(0, 0), b2, voffB);
            PG8_BAR; PG8_WAIT_L(0); PG8_MMA(0, 1, At, B1); PG8_BAR;
            PG8_LDA(At, 0, 1); PG8_STAGE(PG8_SA(0, 0), a2, voffA);
            PG8_BAR; PG8_WAIT_L(0); PG8_MMA(1, 0, At, B0); PG8_BAR; PG8_SCHED;
            PG8_STAGE(PG8_SB(0, 1), b2 + hstep, voffB);
            PG8_WAIT_V(6); PG8_BAR; PG8_MMA(1, 1, At, B1); PG8_BAR;
            PG8_LDB(B0, 1, 0); PG8_SCHED; PG8_LDA(At, 1, 0); PG8_STAGE(PG8_SA(0, 1), a2 + hstep, voffA);
            PG8_WAIT_L(8); PG8_BAR; PG8_WAIT_L(0); PG8_MMA(0, 0, At, B0); PG8_BAR; PG8_SCHED;
            PG8_LDB(B1, 1, 1); PG8_STAGE(PG8_SB(1, 0), b3, voffB);
            PG8_BAR; PG8_WAIT_L(0); PG8_MMA(0, 1, At, B1); PG8_BAR;
            PG8_LDA(At, 1, 1); PG8_STAGE(PG8_SA(1, 0), a3, voffA);
            PG8_BAR; PG8_WAIT_L(0); PG8_MMA(1, 0, At, B0); PG8_BAR; PG8_SCHED;
            PG8_STAGE(PG8_SB(1, 1), b3 + hstep, voffB);
            PG8_WAIT_V(6); PG8_BAR; PG8_MMA(1, 1, At, B1); PG8_BAR;
            }
        }
        if constexpr (ALIGN_EPI) { if (wr == 0) PG8_BAR; }
        if constexpr (!Epi::AFTER_DRAIN) { E(acc, cur, wr, wc, fr, fq); S.done(cur); }
        if (!has_next) break;
#pragma unroll
        for (int a = 0; a < 2; ++a)
#pragma unroll
            for (int b = 0; b < 2; ++b)
#pragma unroll
                for (int m = 0; m < 4; ++m)
#pragma unroll
                    for (int n = 0; n < 2; ++n) acc[a][b][m][n] = (f32x4){0.f, 0.f, 0.f, 0.f};
        cur = nxt; cA = nA; cB = nB; ++ui;
        if constexpr (ALIGN_EPI) { if (wr == 1) PG8_BAR; }
    }
    PG8_WAIT_V(0);
    if constexpr (!ALIGN_EPI) { if (wr == 0) PG8_BAR; }
    PG8_BAR;
    if constexpr (Epi::AFTER_DRAIN) { E.fused(acc, cur, wr, wc, fr, fq, lds, wid, lane); S.done(cur); }
#undef PG8_SA
#undef PG8_SB
#undef PG8_STAGE
#undef PG8_LDA
#undef PG8_LDB
#undef PG8_MMA
#undef PG8_WAIT_V
#undef PG8_WAIT_L
#undef PG8_BAR
#undef PG8_SCHED
}
}

#ifndef MK_SINGLE
#define MK_SINGLE 1
#endif
constexpr int NWAVES = 8;
constexpr int M = 16384, D = 1024, INW = 3328, FF = 4096, SEQ = 8192, NH = 6, HD = 128, PW = 256, DEPTH = 4, HW = 768;
constexpr int SEGL = 512, NSEG = SEQ / SEGL, NCH = SEGL / 64, NHITEMS = 2 * NH * NSEG;
constexpr int NPOOL = M / 256;
constexpr float EPS = 1e-5f;
constexpr int NPHASES = 2 + 6 * DEPTH;
constexpr size_t MiB = 1u << 20;
constexpr size_t WS_LB = 1 * MiB;
constexpr size_t WS_WIN = 2 * MiB, WS_WOUT = 9 * MiB, WS_WUP = 11 * MiB, WS_WDN = 19 * MiB;
constexpr size_t WS_XB = 27 * MiB, WS_Y = 59 * MiB;
constexpr size_t WS_SEGS = 91 * MiB, WS_SEGD = 103 * MiB;
constexpr size_t WS_U = 104 * MiB;
constexpr size_t WS_SS = 232 * MiB;
constexpr size_t WS_END = 241 * MiB;
static_assert(WS_SS + 9 * (size_t)M * 64 <= WS_END && WS_WIN + (size_t)INW * D * 2 <= WS_WOUT && WS_SEGS + (size_t)NHITEMS * 65536 <= WS_SEGD && WS_U + (size_t)M * FF * 2 <= WS_SS, "ws map");
constexpr int LDS_BYTES = 147456;
constexpr int QP = 136, SP = 72, OP = 132;
constexpr int Q_OFF = 0, KT_OFF = 17408, OB_OFF = 0  , KH_OFF = 34816, VT_OFF = 53248, ST_OFF = 71680, PM_OFF = 106496, TOT_OFF = 115712, DV_OFF = 119808, DS_OFF = 120320;
static_assert(64 * OP * 4 <= KH_OFF && DS_OFF + 512 <= 131072, "mixer LDS map");
constexpr int PPP = 264;
constexpr int PP_OFF = 0, WT_OFF = 128 * PPP * 2;
static_assert(WT_OFF + 256 * SP * 2 <= 131072, "pool LDS map");

#define LAS __attribute__((address_space(3)))
typedef unsigned short bf16;
typedef float f32x4 __attribute__((ext_vector_type(4)));
typedef float f32x2 __attribute__((ext_vector_type(2)));
typedef short bf16x8 __attribute__((ext_vector_type(8)));
typedef unsigned u32x4 __attribute__((ext_vector_type(4)));
typedef unsigned u32x2 __attribute__((ext_vector_type(2)));
typedef __bf16 bf16x2_t __attribute__((ext_vector_type(2)));
__device__ __forceinline__ unsigned pk2(float lo, float hi) { f32x2 v = {lo, hi}; bf16x2_t b = __builtin_convertvector(v, bf16x2_t); return __builtin_bit_cast(unsigned, b); }
__device__ __forceinline__ float bflo(unsigned u) { return __uint_as_float(u << 16); }
__device__ __forceinline__ float bfhi(unsigned u) { return __uint_as_float(u & 0xffff0000u); }
__device__ __forceinline__ float wave_sum(float v) {
#pragma unroll
    for (int o = 1; o < 64; o <<= 1) v += __shfl_xor(v, o);
    return v;
}
#define MFMA16(a, b, c) __builtin_amdgcn_mfma_f32_16x16x32_bf16((a), (b), (c), 0, 0, 0)

__device__ __forceinline__ void transpose_item(const float* W, const float* g, int K, int N, bf16* WT, LAS float* scr, int item, int lane) {
    const int nblk = N / 32, kb = item / nblk, nb = item % nblk, k0 = 64 * kb, n0 = 32 * nb;
#pragma unroll 8
    for (int i = 0; i < 32; ++i) { const int kk = 2 * i + (lane >> 5); float v = W[(size_t)(k0 + kk) * N + n0 + (lane & 31)]; if (g) v *= g[k0 + kk]; scr[kk * 33 + (lane & 31)] = v; }
    asm volatile("s_waitcnt lgkmcnt(0)" ::: "memory");
    const int c = lane & 7;
#pragma unroll
    for (int j = 0; j < 4; ++j) { const int n = (lane >> 3) + 8 * j; const LAS float* s = scr + (8 * c) * 33 + n;
        u32x4 o; o.x = pk2(s[0 * 33], s[1 * 33]); o.y = pk2(s[2 * 33], s[3 * 33]); o.z = pk2(s[4 * 33], s[5 * 33]); o.w = pk2(s[6 * 33], s[7 * 33]);
        *(u32x4*)(WT + (size_t)(n0 + n) * K + k0 + 8 * c) = o; }
    asm volatile("s_waitcnt lgkmcnt(0)" ::: "memory");
}
__device__ __forceinline__ int convert_one(LAS unsigned char* lds, const float* W, const float* g, bf16* WT, int K, int N, int base, int gw, int ngw, int wave, int lane) {
    LAS float* scr = (LAS float*)(lds + wave * 16384);
    const int nit = (K / 64) * (N / 32);
    int it = (gw - base % ngw + ngw) % ngw;
    for (; it < nit; it += ngw) transpose_item(W, g, K, N, WT, scr, it, lane);
    return base + nit;
}

template <bool FULL>
__device__ __forceinline__ void hgrn_item(LAS unsigned char* lds, const bf16* U, bf16* Y, float* SEGS, float* SEGD, const float* normg, int item, int tid) {
    const int lane = tid & 63, w = __builtin_amdgcn_readfirstlane(tid >> 6), fr = lane & 15, fq = lane >> 4;
    const int j = item % NSEG, bh = item / NSEG, h = bh % NH, b = bh / NH;
    if (!FULL && j == NSEG - 1) return;
    const int row0 = b * SEQ + j * SEGL;
    LAS bf16* Qs = (LAS bf16*)(lds + Q_OFF); LAS bf16* KT = (LAS bf16*)(lds + KT_OFF); LAS bf16* KH = (LAS bf16*)(lds + KH_OFF); LAS bf16* VT = (LAS bf16*)(lds + VT_OFF);
    LAS bf16* ST = (LAS bf16*)(lds + ST_OFF); LAS bf16* PM = (LAS bf16*)(lds + PM_OFF); LAS float* OB = (LAS float*)(lds + OB_OFF);
    LAS float* TOT = (LAS float*)(lds + TOT_OFF); LAS float* DV = (LAS float*)(lds + DV_OFF); LAS float* DS = (LAS float*)(lds + DS_OFF);
    f32x4 S[8];
#pragma unroll
    for (int vt = 0; vt < 8; ++vt) S[vt] = (f32x4){0.f, 0.f, 0.f, 0.f};
    if (tid < 128) DS[tid] = 0.f;
    if (FULL) {
        for (int i = 0; i < j; ++i) {
            const float* Ki = SEGS + (size_t)(bh * NSEG + i) * 16384; const f32x4 dv = *(const f32x4*)(SEGD + (size_t)(bh * NSEG + i) * 128 + 16 * w + 4 * fq);
#pragma unroll
            for (int vt = 0; vt < 8; ++vt) { const f32x4 kv = *(const f32x4*)(Ki + (size_t)((vt * 8 + w) * 64 + lane) * 4); S[vt] = S[vt] * dv + kv; }
        }
#pragma unroll
        for (int vt = 0; vt < 8; ++vt) { u32x2 o; o.x = pk2(S[vt][0], S[vt][1]); o.y = pk2(S[vt][2], S[vt][3]); *(LAS u32x2*)(ST + (16 * vt + fr) * QP + 16 * w + 4 * fq) = o; }
    }
    __syncthreads();
    for (int c = 0; c < NCH; ++c) {
        const int r0 = row0 + c * 64;
        const bf16* up = U + (size_t)(r0 + 8 * w) * INW + h * HD + 2 * lane;
        unsigned lf2[8], v2[8], q2[8];
#pragma unroll
        for (int jj = 0; jj < 8; ++jj) { lf2[jj] = *(const unsigned*)(up + (size_t)jj * INW + 1024); v2[jj] = *(const unsigned*)(up + (size_t)jj * INW + 1792); q2[jj] = FULL ? *(const unsigned*)(up + (size_t)jj * INW + 256) : 0u; }
        float bl0[8], bl1[8]; float a0 = 0.f, a1 = 0.f;
#pragma unroll
        for (int jj = 0; jj < 8; ++jj) { a0 += bflo(lf2[jj]); a1 += bfhi(lf2[jj]); bl0[jj] = a0; bl1[jj] = a1; }
        *(LAS f32x2*)(TOT + w * 128 + 2 * lane) = (f32x2){a0, a1};
        __syncthreads();
        float p0 = 0.f, p1 = 0.f, t0 = 0.f, t1 = 0.f;
#pragma unroll
        for (int g = 0; g < 8; ++g) { const f32x2 tv = *(const LAS f32x2*)(TOT + g * 128 + 2 * lane); if (g < w) { p0 += tv.x; p1 += tv.y; } t0 += tv.x; t1 += tv.y; }
        if (w == 0) { *(LAS f32x2*)(DV + 2 * lane) = (f32x2){__expf(t0), __expf(t1)}; const f32x2 ds = *(const LAS f32x2*)(DS + 2 * lane); *(LAS f32x2*)(DS + 2 * lane) = (f32x2){ds.x + t0, ds.y + t1}; }
        float kh0[8], kh1[8];
#pragma unroll
        for (int jj = 0; jj < 8; ++jj) {
            const float b0 = p0 + bl0[jj], b1 = p1 + bl1[jj];
            const float k0 = 1.0f - __expf(bflo(lf2[jj])), k1 = 1.0f - __expf(bfhi(lf2[jj]));
            kh0[jj] = k0 * __expf(t0 - b0); kh1[jj] = k1 * __expf(t1 - b1);
            if (FULL) {
                const float bc0 = fmaxf(b0, -80.f), bc1 = fmaxf(b1, -80.f);
                const float e0 = __expf(bc0), e1 = __expf(bc1), i0 = __expf(-bc0), i1 = __expf(-bc1);
                *(LAS unsigned*)(Qs + (8 * w + jj) * QP + 2 * lane) = pk2(bflo(q2[jj]) * e0, bfhi(q2[jj]) * e1);
                *(LAS unsigned*)(KT + (8 * w + jj) * QP + 2 * lane) = pk2(k0 * i0, k1 * i1);
            }
        }
        { u32x4 o; o.x = pk2(kh0[0], kh0[1]); o.y = pk2(kh0[2], kh0[3]); o.z = pk2(kh0[4], kh0[5]); o.w = pk2(kh0[6], kh0[7]); *(LAS u32x4*)(KH + (2 * lane) * SP + 8 * w) = o;
          o.x = pk2(kh1[0], kh1[1]); o.y = pk2(kh1[2], kh1[3]); o.z = pk2(kh1[4], kh1[5]); o.w = pk2(kh1[6], kh1[7]); *(LAS u32x4*)(KH + (2 * lane + 1) * SP + 8 * w) = o;
          o.x = (v2[0] & 0xffffu) | (v2[1] << 16); o.y = (v2[2] & 0xffffu) | (v2[3] << 16); o.z = (v2[4] & 0xffffu) | (v2[5] << 16); o.w = (v2[6] & 0xffffu) | (v2[7] << 16); *(LAS u32x4*)(VT + (2 * lane) * SP + 8 * w) = o;
          o.x = (v2[0] >> 16) | (v2[1] & 0xffff0000u); o.y = (v2[2] >> 16) | (v2[3] & 0xffff0000u); o.z = (v2[4] >> 16) | (v2[5] & 0xffff0000u); o.w = (v2[6] >> 16) | (v2[7] & 0xffff0000u); *(LAS u32x4*)(VT + (2 * lane + 1) * SP + 8 * w) = o; }
        __syncthreads();
        const int tt = w >> 1;
        f32x4 oa[4];
        if constexpr (FULL) {
#pragma unroll
            for (int ti = 0; ti < 2; ++ti) { const int ts = (w & 1) * 2 + ti; f32x4 pa = (f32x4){0.f, 0.f, 0.f, 0.f};
                if (ts <= tt) {
#pragma unroll
                    for (int kk = 0; kk < 4; ++kk) { const bf16x8 a = *(const LAS bf16x8*)(KT + (ts * 16 + fr) * QP + kk * 32 + 8 * fq); const bf16x8 bq = *(const LAS bf16x8*)(Qs + (tt * 16 + fr) * QP + kk * 32 + 8 * fq); pa = MFMA16(a, bq, pa); }
                    if (ts == tt) {
#pragma unroll
                        for (int i = 0; i < 4; ++i) if (4 * fq + i > fr) pa[i] = 0.f;
                    }
                }
                u32x2 o; o.x = pk2(pa[0], pa[1]); o.y = pk2(pa[2], pa[3]); *(LAS u32x2*)(PM + (tt * 16 + fr) * SP + ts * 16 + 4 * fq) = o; }
            bf16x8 qf[4];
#pragma unroll
            for (int kk = 0; kk < 4; ++kk) qf[kk] = *(const LAS bf16x8*)(Qs + (tt * 16 + fr) * QP + kk * 32 + 8 * fq);
#pragma unroll
            for (int vi = 0; vi < 4; ++vi) { const int vt = (w & 1) * 4 + vi; oa[vi] = (f32x4){0.f, 0.f, 0.f, 0.f};
#pragma unroll
                for (int kk = 0; kk < 4; ++kk) { const bf16x8 sf = *(const LAS bf16x8*)(ST + (vt * 16 + fr) * QP + kk * 32 + 8 * fq); oa[vi] = MFMA16(sf, qf[kk], oa[vi]); } }
            __syncthreads();
            bf16x8 pf[2];
#pragma unroll
            for (int kk = 0; kk < 2; ++kk) pf[kk] = *(const LAS bf16x8*)(PM + (tt * 16 + fr) * SP + kk * 32 + 8 * fq);
#pragma unroll
            for (int vi = 0; vi < 4; ++vi) { const int vt = (w & 1) * 4 + vi;
#pragma unroll
                for (int kk = 0; kk < 2; ++kk) { const bf16x8 vf = *(const LAS bf16x8*)(VT + (vt * 16 + fr) * SP + kk * 32 + 8 * fq); oa[vi] = MFMA16(vf, pf[kk], oa[vi]); } }
        }
        { const f32x4 dv = *(const LAS f32x4*)(DV + 16 * w + 4 * fq); bf16x8 kf[2];
#pragma unroll
          for (int kk = 0; kk < 2; ++kk) kf[kk] = *(const LAS bf16x8*)(KH + (16 * w + fr) * SP + kk * 32 + 8 * fq);
#pragma unroll
          for (int vt = 0; vt < 8; ++vt) { S[vt] = S[vt] * dv;
#pragma unroll
              for (int kk = 0; kk < 2; ++kk) { const bf16x8 vf = *(const LAS bf16x8*)(VT + (vt * 16 + fr) * SP + kk * 32 + 8 * fq); S[vt] = MFMA16(kf[kk], vf, S[vt]); } } }
        if constexpr (FULL) {
            __syncthreads();
#pragma unroll
            for (int vt = 0; vt < 8; ++vt) { u32x2 o; o.x = pk2(S[vt][0], S[vt][1]); o.y = pk2(S[vt][2], S[vt][3]); *(LAS u32x2*)(ST + (16 * vt + fr) * QP + 16 * w + 4 * fq) = o; }
#pragma unroll
            for (int vi = 0; vi < 4; ++vi) { const int vt = (w & 1) * 4 + vi; *(LAS f32x4*)(OB + (tt * 16 + fr) * OP + vt * 16 + 4 * fq) = oa[vi]; }
            __syncthreads();
            const int t = tid >> 3, vs = (tid & 7) * 16;
            f32x4 o4[4]; float ssq = 0.f;
#pragma unroll
            for (int q = 0; q < 4; ++q) { o4[q] = *(const LAS f32x4*)(OB + t * OP + vs + 4 * q); ssq += (o4[q][0] * o4[q][0] + o4[q][1] * o4[q][1]) + (o4[q][2] * o4[q][2] + o4[q][3] * o4[q][3]); }
            ssq += __shfl_xor(ssq, 1); ssq += __shfl_xor(ssq, 2); ssq += __shfl_xor(ssq, 4);
            const float rs = rsqrtf(ssq * (1.0f / 128.0f) + EPS);
            const bf16* gp = U + (size_t)(r0 + t) * INW + 2560 + h * HD + vs;
            const u32x4 g0 = *(const u32x4*)gp, g1 = *(const u32x4*)(gp + 8);
            const float* ng = normg + h * HD + vs;
            const f32x4 n0 = *(const f32x4*)ng, n1 = *(const f32x4*)(ng + 4), n2 = *(const f32x4*)(ng + 8), n3 = *(const f32x4*)(ng + 12);
            u32x4 y0, y1;
            y0.x = pk2(o4[0][0] * rs * n0[0] * bflo(g0.x), o4[0][1] * rs * n0[1] * bfhi(g0.x)); y0.y = pk2(o4[0][2] * rs * n0[2] * bflo(g0.y), o4[0][3] * rs * n0[3] * bfhi(g0.y));
            y0.z = pk2(o4[1][0] * rs * n1[0] * bflo(g0.z), o4[1][1] * rs * n1[1] * bfhi(g0.z)); y0.w = pk2(o4[1][2] * rs * n1[2] * bflo(g0.w), o4[1][3] * rs * n1[3] * bfhi(g0.w));
            y1.x = pk2(o4[2][0] * rs * n2[0] * bflo(g1.x), o4[2][1] * rs * n2[1] * bfhi(g1.x)); y1.y = pk2(o4[2][2] * rs * n2[2] * bflo(g1.y), o4[2][3] * rs * n2[3] * bfhi(g1.y));
            y1.z = pk2(o4[3][0] * rs * n3[0] * bflo(g1.z), o4[3][1] * rs * n3[1] * bfhi(g1.z)); y1.w = pk2(o4[3][2] * rs * n3[2] * bflo(g1.w), o4[3][3] * rs * n3[3] * bfhi(g1.w));
            bf16* yp = Y + (size_t)(r0 + t) * D + PW + h * HD + vs;
            *(u32x4*)yp = y0; *(u32x4*)(yp + 8) = y1;
        }
    }
    if (!FULL) {
#pragma unroll
        for (int vt = 0; vt < 8; ++vt) *(f32x4*)(SEGS + (size_t)item * 16384 + (size_t)((vt * 8 + w) * 64 + lane) * 4) = S[vt];
        if (tid < 128) SEGD[(size_t)item * 128 + tid] = __expf(DS[tid]);
    }
    __syncthreads();
}

template <int WIN>
__device__ __forceinline__ void pool_run(LAS bf16* PP, const bf16* U, int R, int tl0, int g, int pair) {
    const bf16* up = U + (size_t)R * INW + g * 64 + 2 * pair; const int tseq0 = R % SEQ;
    unsigned xv[16 + WIN - 1];
#pragma unroll
    for (int i = 0; i < 16 + WIN - 1; ++i) { const int tt = i - (WIN - 1); xv[i] = (tseq0 + tt >= 0) ? *(const unsigned*)(up + (long)tt * INW) : 0u; }
    float s0 = 0.f, s1 = 0.f;
#pragma unroll
    for (int i = 0; i < WIN - 1; ++i) { s0 += bflo(xv[i]); s1 += bfhi(xv[i]); }
#pragma unroll
    for (int jj = 0; jj < 16; ++jj) { const float x0 = bflo(xv[jj + WIN - 1]), x1 = bfhi(xv[jj + WIN - 1]); s0 += x0; s1 += x1;
        const int cn = tseq0 + jj + 1; const float ic = 1.0f / (float)(cn < WIN ? cn : WIN);
        *(LAS unsigned*)(PP + (tl0 + jj) * PPP + g * 64 + 2 * pair) = pk2(s0 * ic - x0, s1 * ic - x1);
        s0 -= bflo(xv[jj]); s1 -= bfhi(xv[jj]); }
}
__device__ __forceinline__ void pool_item(LAS unsigned char* lds, const bf16* U, bf16* Y, const float* poolw, const float* pscale, int item, int tid) {
    const int lane = tid & 63, w = __builtin_amdgcn_readfirstlane(tid >> 6), fr = lane & 15, fq = lane >> 4;
    LAS bf16* PP = (LAS bf16*)(lds + PP_OFF); LAS bf16* WT = (LAS bf16*)(lds + WT_OFF);
    for (int i = 0; i < 32; ++i) { const int idx = tid + 512 * i; const int g = idx >> 12, c = (idx >> 6) & 63, d = idx & 63; WT[(g * 64 + d) * SP + c] = (bf16)(pk2(poolw[idx], 0.f) & 0xffffu); }
    for (int hh = 0; hh < 2; ++hh) {
        const int R0 = item * 256 + hh * 128;
#pragma unroll 1
        for (int rr = 0; rr < 2; ++rr) { const int g = w & 3, tq = w >> 2, pair = lane & 31, sub = lane >> 5, tl0 = tq * 64 + sub * 32 + rr * 16;
          if (g == 0) pool_run<2>(PP, U, R0 + tl0, tl0, 0, pair); else if (g == 1) pool_run<4>(PP, U, R0 + tl0, tl0, 1, pair); else if (g == 2) pool_run<8>(PP, U, R0 + tl0, tl0, 2, pair); else pool_run<16>(PP, U, R0 + tl0, tl0, 3, pair); }
        __syncthreads();
#pragma unroll 1
        for (int g = 0; g < 4; ++g) { bf16x8 pf[2];
#pragma unroll
            for (int kk = 0; kk < 2; ++kk) pf[kk] = *(const LAS bf16x8*)(PP + (16 * w + fr) * PPP + g * 64 + kk * 32 + 8 * fq);
#pragma unroll
            for (int dt = 0; dt < 4; ++dt) { f32x4 acc = (f32x4){0.f, 0.f, 0.f, 0.f};
#pragma unroll
                for (int kk = 0; kk < 2; ++kk) { const bf16x8 wf = *(const LAS bf16x8*)(WT + (g * 64 + dt * 16 + fr) * SP + kk * 32 + 8 * fq); acc = MFMA16(wf, pf[kk], acc); }
                const int dcol = g * 64 + dt * 16 + 4 * fq; const f32x4 sc = *(const f32x4*)(pscale + dcol);
                u32x2 o; o.x = pk2(acc[0] * sc[0], acc[1] * sc[1]); o.y = pk2(acc[2] * sc[2], acc[3] * sc[3]);
                *(u32x2*)(Y + (size_t)(R0 + 16 * w + fr) * D + dcol) = o; } }
        __syncthreads();
    }
}

struct Args { const float* in[12]; float* out; unsigned char* ws; int ph_lo, ph_hi; };
static_assert(sizeof(Args) == 12 * 8 + 8 + 8 + 8, "Args has no padding");

__global__ void __launch_bounds__(NWAVES * 64, 2) mk_fwd(Args args) {
    extern __shared__ __attribute__((aligned(16))) unsigned char lds_raw[];
    LAS unsigned char* lds = (LAS unsigned char*)lds_raw;
    const int tid = threadIdx.x, lane = tid & 63, wave = __builtin_amdgcn_readfirstlane(tid >> 6);
    const int G = gridDim.x, bx = blockIdx.x, gw = bx * NWAVES + wave, ngw = G * NWAVES;
    unsigned char* ws = args.ws;
    const float* x_in = args.in[0]; const float* norm_mix_g = args.in[1]; const float* w_in = args.in[2]; const float* pool_w = args.in[3]; const float* pool_scale = args.in[4];
    const float* lb_logits = args.in[5]; const float* hgrn_norm_g = args.in[6]; const float* w_out = args.in[7]; const float* norm_mlp_g = args.in[8]; const float* w_up = args.in[9];
    const float* w_down = args.in[10]; const float* final_g = args.in[11];
    float* X = args.out;
#define WSPTRS(wsb) bf16* WIN = (bf16*)((wsb) + WS_WIN); bf16* WOUT = (bf16*)((wsb) + WS_WOUT); bf16* WUP = (bf16*)((wsb) + WS_WUP); bf16* WDN = (bf16*)((wsb) + WS_WDN); \
    bf16* XB = (bf16*)((wsb) + WS_XB); bf16* Yb = (bf16*)((wsb) + WS_Y); bf16* U = (bf16*)((wsb) + WS_U); bf16* Hb = (bf16*)((wsb) + WS_U); \
    float* SEGS = (float*)((wsb) + WS_SEGS); float* SEGD = (float*)((wsb) + WS_SEGD); float* SS = (float*)((wsb) + WS_SS); float* LB = (float*)((wsb) + WS_LB);
    const int lo = args.ph_lo, hi = args.ph_hi;
#if MK_SINGLE
    cg::grid_group grid = cg::this_grid();
#define SEAM(k) do { if ((k) + 1 < hi) grid.sync(); } while (0)
#else
#define SEAM(k) do { } while (0)
#endif
#define IN(k) (lo <= (k) && (k) < hi)

    if (IN(0)) {
        WSPTRS(ws)
        if (bx == 0) for (int ch = tid; ch < HW; ch += NWAVES * 64) {
            float l0 = lb_logits[ch], l1 = lb_logits[HW + ch], l2 = lb_logits[2 * HW + ch], l3 = lb_logits[3 * HW + ch];
            const float mx = fmaxf(fmaxf(l0, l1), fmaxf(l2, l3)); l0 = expf(l0 - mx); l1 = expf(l1 - mx); l2 = expf(l2 - mx); l3 = expf(l3 - mx);
            const float inv = 1.0f / (l0 + l1 + l2 + l3);
            LB[ch] = 0.f; LB[HW + ch] = l1 * inv; LB[2 * HW + ch] = (l1 + l2) * inv; LB[3 * HW + ch] = (l1 + l2 + l3) * inv; }
        (void)convert_one(lds, w_in, norm_mix_g, WIN, D, INW, 0, gw, ngw, wave, lane);
        for (int m = gw; m < M; m += ngw) {
            const f32x4* xr = (const f32x4*)(x_in + (size_t)m * D) + lane; f32x4 v[4]; float s = 0.f;
#pragma unroll
            for (int j = 0; j < 4; ++j) { v[j] = xr[64 * j]; s += (v[j][0] * v[j][0] + v[j][1] * v[j][1]) + (v[j][2] * v[j][2] + v[j][3] * v[j][3]); }
            s = wave_sum(s);
            f32x4* xo = (f32x4*)(X + (size_t)m * D) + lane; u32x2* bo = (u32x2*)(XB + (size_t)m * D) + lane;
#pragma unroll
            for (int j = 0; j < 4; ++j) { xo[64 * j] = v[j]; u32x2 o; o.x = pk2(v[j][0], v[j][1]); o.y = pk2(v[j][2], v[j][3]); bo[64 * j] = o; }
            if (lane < 16) SS[(size_t)m * 16 + lane] = (lane == 0) ? s : 0.f;
        }
        SEAM(0);
    }
#pragma unroll 1
    for (int l = 0; l < DEPTH; ++l) {
        const int pb = 1 + 6 * l;
        int tid_l = threadIdx.x; asm volatile("" : "+v"(tid_l));
        unsigned char* ws_l = ws; asm volatile("" : "+s"(ws_l));
        WSPTRS(ws_l)
        if (IN(pb)) {
            pg8::Gemm g{XB, WIN, M, INW, D}; pg8::StaticOrder S; S.init(M, INW, G, bx);
#if defined(DBG_EXP) && DBG_EXP == 1
            pg8::EpiAct E{U, INW, SS + (size_t)(l == 3 ? 0 : 2 * l) * M * 16, LB + l * HW, 1};
#elif defined(DBG_EXP) && DBG_EXP == 2
            pg8::EpiAct E{U, INW, SS + (size_t)(2 * l) * M * 16, LB + (l == 3 ? 2 : l) * HW, 1};
#else
            pg8::EpiAct E{U, INW, SS + (size_t)(2 * l) * M * 16, LB + l * HW, 1};
#endif
            pg8::gemm_phase<pg8::EpiAct, pg8::StaticOrder, true, true>(lds, g, S, E);
            SEAM(pb);
        }
        if (IN(pb + 1)) {
            for (int it = bx; it < NHITEMS + NPOOL; it += G) {
                if (it < NHITEMS) hgrn_item<false>(lds, U, Yb, SEGS, SEGD, hgrn_norm_g + l * HW, it, tid_l);
                else pool_item(lds, U, Yb, pool_w + (size_t)l * 16384, pool_scale + l * PW, it - NHITEMS, tid_l);
            }
            __syncthreads();
            int cb = convert_one(lds, w_out + (size_t)l * D * D, nullptr, WOUT, D, D, 0, gw, ngw, wave, lane);
            cb = convert_one(lds, w_up + (size_t)l * D * FF, norm_mlp_g + l * D, WUP, D, FF, cb, gw, ngw, wave, lane);
            cb = convert_one(lds, w_down + (size_t)l * FF * D, nullptr, WDN, FF, D, cb, gw, ngw, wave, lane);
            if (l + 1 < DEPTH) cb = convert_one(lds, w_in + (size_t)(l + 1) * D * INW, norm_mix_g + (l + 1) * D, WIN, D, INW, cb, gw, ngw, wave, lane);
            __syncthreads();
            SEAM(pb + 1);
        }
        if (IN(pb + 2)) {
            for (int it = bx; it < NHITEMS; it += G) hgrn_item<true>(lds, U, Yb, SEGS, SEGD, hgrn_norm_g + l * HW, it, tid_l);
            SEAM(pb + 2);
        }
        if (IN(pb + 3)) {
            pg8::Gemm g{Yb, WOUT, M, D, D}; pg8::StaticOrder S; S.init(M, D, G, bx);
            pg8::EpiResid E{X, XB, SS + (size_t)(2 * l + 1) * M * 16};
            pg8::gemm_phase<pg8::EpiResid, pg8::StaticOrder, true, true>(lds, g, S, E);
            SEAM(pb + 3);
        }
        if (IN(pb + 4)) {
            pg8::Gemm g{XB, WUP, M, FF, D}; pg8::StaticOrder S; S.init(M, FF, G, bx);
            pg8::EpiAct E{Hb, FF, SS + (size_t)(2 * l + 1) * M * 16, nullptr, 0};
            pg8::gemm_phase<pg8::EpiAct, pg8::StaticOrder, true, true>(lds, g, S, E);
            SEAM(pb + 4);
        }
        if (IN(pb + 5)) {
            pg8::Gemm g{Hb, WDN, M, D, FF}; pg8::StaticOrder S; S.init(M, D, G, bx);
            pg8::EpiResid E{X, XB, SS + (size_t)(2 * l + 2) * M * 16};
            pg8::gemm_phase<pg8::EpiResid, pg8::StaticOrder, true, true>(lds, g, S, E);
            SEAM(pb + 5);
        }
    }
    if (IN(NPHASES - 1)) {
        const float* ssf = (const float*)(ws + WS_SS) + (size_t)(2 * DEPTH) * M * 16;
        for (int m = gw; m < M; m += ngw) {
            const float rs = rsqrtf(wave_sum(lane < 16 ? ssf[(size_t)m * 16 + lane] : 0.f) * (1.0f / D) + EPS);
            f32x4* xr = (f32x4*)(X + (size_t)m * D) + lane; const f32x4* gr = (const f32x4*)final_g + lane;
#pragma unroll
            for (int j = 0; j < 4; ++j) xr[64 * j] = xr[64 * j] * rs * gr[64 * j];
        }
    }
#undef IN
#undef SEAM
}

__global__ void dbg_digest4(const float* segs, const float* segd, const unsigned short* y, float* out, int n) { int i = blockIdx.x * blockDim.x + threadIdx.x; if (i >= n) return;
    const int ns = 180 * 16384; float v;
    if (i < 192 * 16384) { const int item = i / 16384; v = (item % 16 == 15) ? 0.f : segs[i]; } else if (i < 192 * 16384 + 192 * 128) { const int k = i - 192 * 16384; v = ((k / 128) % 16 == 15) ? 0.f : segd[k]; }
    else if (i < 4 * 1048576) v = 0.f; else { const int k = i - 4 * 1048576; const int r = k / 256, c = k % 256; v = (r < M) ? __uint_as_float((unsigned)y[(size_t)r * 1024 + c] << 16) : 0.f; }
    out[i] = v; }
__global__ void dbg_digest5(const unsigned short* u, float* out, int n) { int i = blockIdx.x * blockDim.x + threadIdx.x; if (i >= n) return; const int r = i / 1024, c = i % 1024;
    const unsigned short* p = u + (size_t)r * 3328 + c; float v = __uint_as_float((unsigned)p[0] << 16) + 2.f * __uint_as_float((unsigned)p[1024] << 16) + 3.f * __uint_as_float((unsigned)p[2048] << 16); if (c < 256) v += 4.f * __uint_as_float((unsigned)p[3072] << 16); out[i] = v; }
__global__ void dbg_digest6(const unsigned short* u, float* out, int n) { int i = blockIdx.x * blockDim.x + threadIdx.x; if (i >= n) return; const int r = i / 1024, c = i % 1024;
    out[i] = (c < 768) ? __uint_as_float((unsigned)u[(size_t)r * 3328 + 1024 + c] << 16) : 0.f; }
__global__ void dbg_digest(const unsigned short* src, float* out, int n) { int i = blockIdx.x * blockDim.x + threadIdx.x; if (i < n) out[i] = __uint_as_float((unsigned)src[i] << 16); }
extern "C" void kernel_launch(void* const* d_in, const int* in_sizes, int n_in, void* d_out, int out_size, void* d_ws, size_t ws_size, hipStream_t stream) {
    static int grid = 0;
    if (grid == 0) {
        if (n_in != 12 || in_sizes[0] != M * D || out_size != M * D || ws_size < WS_END) { fprintf(stderr, "kernel_launch: unexpected shapes (n_in %d, in0 %d, out %d, ws %zu)\n", n_in, n_in > 0 ? in_sizes[0] : -1, out_size, ws_size); grid = -1; return; }
        int dev = 0, cus = 0, per_cu = 0;
        if (hipGetDevice(&dev) != hipSuccess || hipDeviceGetAttribute(&cus, hipDeviceAttributeMultiprocessorCount, dev) != hipSuccess) { grid = -1; return; }
        if (hipFuncSetAttribute((const void*)mk_fwd, hipFuncAttributeMaxDynamicSharedMemorySize, LDS_BYTES) != hipSuccess) { fprintf(stderr, "kernel_launch: hipFuncSetAttribute failed\n"); grid = -1; return; }
        if (hipOccupancyMaxActiveBlocksPerMultiprocessor(&per_cu, (const void*)mk_fwd, NWAVES * 64, LDS_BYTES) != hipSuccess || per_cu < 1) { fprintf(stderr, "kernel_launch: occupancy query says %d\n", per_cu); per_cu = 1; }
        (void)hipGetLastError();
        grid = cus * (per_cu < 1 ? 1 : per_cu);
        if (grid > 256) grid = 256;
    }
    if (grid < 0) return;
    Args a{};
    for (int i = 0; i < 12; ++i) a.in[i] = (const float*)d_in[i];
    a.out = (float*)d_out; a.ws = (unsigned char*)d_ws;
#if MK_SINGLE
#ifdef DBG_STOP
    a.ph_lo = 0; a.ph_hi = DBG_STOP;
#else
    a.ph_lo = 0; a.ph_hi = NPHASES;
#endif
    void* kargs[] = {&a};
    hipError_t e = hipLaunchCooperativeKernel((const void*)mk_fwd, dim3(grid), dim3(NWAVES * 64), kargs, LDS_BYTES, stream);
    if (e != hipSuccess) fprintf(stderr, "kernel_launch: cooperative launch failed: %s (grid %d)\n", hipGetErrorString(e), grid);
#if defined(DBG_DIGEST) && DBG_DIGEST == 4
    hipLaunchKernelGGL(dbg_digest4, dim3(M * D / 256), dim3(256), 0, stream, (const float*)((char*)d_ws + WS_SEGS), (const float*)((char*)d_ws + WS_SEGD), (const unsigned short*)((char*)d_ws + WS_Y), (float*)d_out, M * D);
#elif defined(DBG_DIGEST) && DBG_DIGEST == 6
    hipLaunchKernelGGL(dbg_digest6, dim3(M * D / 256), dim3(256), 0, stream, (const unsigned short*)((char*)d_ws + WS_U), (float*)d_out, M * D);
#elif defined(DBG_DIGEST) && DBG_DIGEST == 5
    hipLaunchKernelGGL(dbg_digest5, dim3(M * D / 256), dim3(256), 0, stream, (const unsigned short*)((char*)d_ws + WS_U), (float*)d_out, M * D);
#elif defined(DBG_DIGEST)
    hipLaunchKernelGGL(dbg_digest, dim3(M * D / 256), dim3(256), 0, stream, (const unsigned short*)((char*)d_ws + (DBG_DIGEST == 1 ? WS_Y : (DBG_DIGEST == 2 ? WS_U : WS_XB))), (float*)d_out, M * D);
#endif
#else
#ifndef DBG_STOP
#define DBG_STOP NPHASES
#endif
    for (int p = 0; p < DBG_STOP; ++p) { a.ph_lo = p; a.ph_hi = p + 1; hipLaunchKernelGGL(mk_fwd, dim3(grid), dim3(NWAVES * 64), LDS_BYTES, stream, a); }
#if defined(DBG_DIGEST) && DBG_DIGEST == 4
    hipLaunchKernelGGL(dbg_digest4, dim3(M * D / 256), dim3(256), 0, stream, (const float*)((char*)d_ws + WS_SEGS), (const float*)((char*)d_ws + WS_SEGD), (const unsigned short*)((char*)d_ws + WS_Y), (float*)d_out, M * D);
#elif defined(DBG_DIGEST)
    hipLaunchKernelGGL(dbg_digest, dim3(M * D / 256), dim3(256), 0, stream, (const unsigned short*)((char*)d_ws + (DBG_DIGEST == 1 ? WS_Y : WS_U)), (float*)d_out, M * D);
#endif
#endif
}
```

```cpp
#include <hip/hip_runtime.h>
#include <hip/hip_cooperative_groups.h>
#include <cstdio>
#include <cstdint>
namespace cg = cooperative_groups;
namespace pg8 {
#define PG8_LAS __attribute__((address_space(3)))
typedef unsigned short bf16_t;
typedef short bf16x8 __attribute__((ext_vector_type(8)));
typedef float f32x4 __attribute__((ext_vector_type(4)));
typedef unsigned u32x4 __attribute__((ext_vector_type(4)));
constexpr int BM = 256, BK = 64, HALF = 128, HTB = HALF * BK * 2  , STAGE_BYTES = 8 * HTB, NXCD = 8, WGM = 8;

__host__ __device__ __forceinline__ int lds_byte(int r, int c) { const int st = (r >> 4) * 2 + (c >> 5), rr = r & 15, cc = c & 31, ob = rr * 64 + cc * 2; return st * 1024 + (ob ^ (((ob >> 9) & 1) << 5)); }
__host__ __device__ __forceinline__ void stage_rc(int b, int& R, int& C) { const int st = b / 1024, sb = b % 1024, swz = sb ^ (((sb >> 9) & 1) << 5); R = (st >> 1) * 16 + swz / 64; C = (st & 1) * 32 + (swz % 64) / 2; }
__host__ __device__ __forceinline__ int perm32(int rho) { const int n = rho >> 4, i = rho & 15; return 8 * (i >> 2) + 4 * n + (i & 3); }

struct Unit { int pm, pn; };
struct Gemm { const bf16_t* A; const bf16_t* Bt; int M, N, K; };

struct StaticOrder {
    int nM, nN, nwg, G, c;
    __host__ __device__ void init(int M, int N, int G_, int c_) { nM = M / BM; nN = N / BM; nwg = nM * nN; G = G_; c = c_; }
    __host__ __device__ bool next(int i, Unit& u) const {
        const long L = (long)i * G + c; if (L >= nwg) return false;
        int wgid = (int)L; { const int q = nwg / NXCD, r = nwg % NXCD, xcd = wgid % NXCD, off = wgid / NXCD; wgid = (xcd < r ? xcd * (q + 1) : r * (q + 1) + (xcd - r) * q) + off; }
        const int nig = WGM * nN, gid = wgid / nig, fm = gid * WGM, gsz = (nM - fm) < WGM ? (nM - fm) : WGM;
        u.pm = fm + ((wgid % nig) % gsz); u.pn = (wgid % nig) / gsz; return true;
    }
    __device__ __forceinline__ void a_ready(const Unit&) const {}
    __device__ __forceinline__ void done(const Unit&) const {}
};

__device__ __forceinline__ unsigned cvt_pk_bf16(float lo, float hi) { unsigned r; asm volatile("v_cvt_pk_bf16_f32 %0, %1, %2" : "=v"(r) : "v"(lo), "v"(hi)); return r; }
typedef float f32x2 __attribute__((ext_vector_type(2)));

typedef unsigned u32x2 __attribute__((ext_vector_type(2)));
__device__ __forceinline__ float fast_rcp(float x) { return __builtin_amdgcn_rcpf(x); }
__device__ __forceinline__ float silu_f(float v) { return v * fast_rcp(1.0f + __expf(-v)); }
struct EpiAct {
    static constexpr bool PERM = true, AFTER_DRAIN = false;
    bf16_t* O; int ldc; const float* ss; const float* lb; int is_in;
    __device__ __forceinline__ void operator()(const f32x4 (&acc)[2][2][4][2], const Unit& u, int wr, int wc, int fr, int fq) const {
        const int row0 = u.pm * BM + wr * 64 + fr; const int col0 = u.pn * BM + wc * 32 + 8 * fq;
        int mode = 3;
        if (is_in) { const int t = u.pn; mode = (t == 0) ? 0 : (t <= 3 ? 1 : (t <= 6 ? 2 : (t <= 9 ? 0 : 1))); }
#pragma unroll
        for (int ai = 0; ai < 2; ++ai)
#pragma unroll
            for (int m = 0; m < 4; ++m) { const int r = row0 + ai * HALF + m * 16; const f32x4* sp = (const f32x4*)(ss + (size_t)r * 16); const f32x4 s0 = sp[0], s1 = sp[1], s2 = sp[2], s3 = sp[3];
                const float rs = rsqrtf((((s0[0] + s0[1]) + (s0[2] + s0[3])) + ((s1[0] + s1[1]) + (s1[2] + s1[3])) + (((s2[0] + s2[1]) + (s2[2] + s2[3])) + ((s3[0] + s3[1]) + (s3[2] + s3[3])))) * (1.0f / 1024.0f) + 1e-5f);
                bf16_t* rowp = O + (size_t)r * ldc + col0;
#pragma unroll
                for (int bj = 0; bj < 2; ++bj) { f32x4 v[2]; v[0] = acc[ai][bj][m][0] * rs; v[1] = acc[ai][bj][m][1] * rs;
                    if (mode == 1) {
#pragma unroll
                        for (int n = 0; n < 2; ++n)
#pragma unroll
                            for (int e = 0; e < 4; ++e) v[n][e] = silu_f(v[n][e]);
                    } else if (mode == 2) {
#pragma unroll
                        for (int n = 0; n < 2; ++n)
                            { const f32x4 lv = *(const f32x4*)(lb + (col0 - 1024) + bj * HALF + 4 * n);
#pragma unroll
                            for (int e = 0; e < 4; ++e) { const float s = fast_rcp(1.0f + __expf(-v[n][e])); const float l = lv[e]; v[n][e] = __logf(l + (1.0f - l) * s); } }
                    } else if (mode == 3) {
#pragma unroll
                        for (int n = 0; n < 2; ++n)
#pragma unroll
                            for (int e = 0; e < 4; ++e) { const float t = fmaxf(v[n][e], 0.f); v[n][e] = t * t; }
                    }
                    u32x4 w; w.x = cvt_pk_bf16(v[0][0], v[0][1]); w.y = cvt_pk_bf16(v[0][2], v[0][3]); w.z = cvt_pk_bf16(v[1][0], v[1][1]); w.w = cvt_pk_bf16(v[1][2], v[1][3]);
                    *(u32x4*)(rowp + bj * HALF) = w; }
                asm volatile("" ::: "memory"); }
    }
};
struct EpiResid {
    static constexpr bool PERM = false, AFTER_DRAIN = false;
    float* X; bf16_t* XB; float* ss;
    __device__ __forceinline__ void operator()(const f32x4 (&acc)[2][2][4][2], const Unit& u, int wr, int wc, int fr, int fq) const {
        const int col0 = u.pn * BM + wc * 32 + 4 * fq;
#pragma unroll
        for (int ai = 0; ai < 2; ++ai)
#pragma unroll
            for (int m = 0; m < 4; ++m) { const int r = u.pm * BM + ai * HALF + wr * 64 + m * 16 + fr; const size_t off = (size_t)r * 1024 + col0; float sq = 0.f;
#pragma unroll
                for (int bj = 0; bj < 2; ++bj)
#pragma unroll
                    for (int n = 0; n < 2; ++n) { float* p = X + off + bj * HALF + n * 16; const f32x4 o = *(const f32x4*)p + acc[ai][bj][m][n]; *(f32x4*)p = o;
                        sq += (o[0] * o[0] + o[1] * o[1]) + (o[2] * o[2] + o[3] * o[3]);
                        u32x2 w; w.x = cvt_pk_bf16(o[0], o[1]); w.y = cvt_pk_bf16(o[2], o[3]); *(u32x2*)(XB + off + bj * HALF + n * 16) = w; }
                sq += __shfl_xor(sq, 16); sq += __shfl_xor(sq, 32);
                if (fq == 0) ss[(size_t)r * 16 + u.pn * 4 + wc] = sq;
                asm volatile("" ::: "memory"); }
    }
};

template <class Epi, class Sched, bool ALIGN_EPI = false, bool SP2 = false>
__device__ __forceinline__ void gemm_phase(PG8_LAS unsigned char* lds, const Gemm g, const Sched& S, const Epi& E) {
    int tid_ = threadIdx.x; asm volatile("" : "+v"(tid_));
    const int tid = tid_, wid = __builtin_amdgcn_readfirstlane(tid >> 6), lane = tid & 63, wr = wid >> 2, wc = wid & 3, fr = lane & 15, fq = lane >> 4;
    const int K = g.K, nt = K / BK;
    unsigned voffA[2], voffB[2];
#pragma unroll
    for (int i = 0; i < 2; ++i) { int R, C; stage_rc(tid * 16 + i * 8192, R, C); const int Rb = Epi::PERM ? ((R & ~31) + perm32(R & 31)) : R;
        voffA[i] = (unsigned)(R * K + C) * 2u; voffB[i] = (unsigned)(Rb * K + C) * 2u; }
    const size_t kstep = (size_t)(BK * 2);
    const size_t hstep = (size_t)HALF * K * 2;
    const size_t tstep = 2 * hstep;
    const unsigned ldsw = (unsigned)wid * 1024u;
    const int aoff = lds_byte(wr * 64 + fr, fq * 8), boff = lds_byte(wc * 32 + fr, fq * 8);
#define PG8_SA(b, h) (((b) * 2 + (h)) * HTB)
#define PG8_SB(b, h) ((4 + (b) * 2 + (h)) * HTB)
#define PG8_STAGE(bufoff, gbase, voff) do { _Pragma("unroll") for (int _i = 0; _i < 2; ++_i) \
        __builtin_amdgcn_global_load_lds((const unsigned*)((const char*)(gbase) + (voff)[_i]), (PG8_LAS unsigned*)(lds + (bufoff) + ldsw + _i * 8192), 16, 0, 0); } while (0)
#define PG8_LDA(dst, b, h) do { _Pragma("unroll") for (int m = 0; m < 4; ++m) _Pragma("unroll") for (int k = 0; k < 2; ++k) dst[m][k] = *(const PG8_LAS bf16x8*)(lds + PG8_SA(b, h) + aoff + m * 2048 + k * 1024); } while (0)
#define PG8_LDB(dst, b, h) do { _Pragma("unroll") for (int n = 0; n < 2; ++n) _Pragma("unroll") for (int k = 0; k < 2; ++k) dst[n][k] = *(const PG8_LAS bf16x8*)(lds + PG8_SB(b, h) + boff + n * 2048 + k * 1024); } while (0)
#define PG8_MMA(ai, bj, At, Bt) do { __builtin_amdgcn_s_setprio(1); _Pragma("unroll") for (int m = 0; m < 4; ++m) _Pragma("unroll") for (int n = 0; n < 2; ++n) _Pragma("unroll") for (int k = 0; k < 2; ++k) \
        acc[ai][bj][m][n] = __builtin_amdgcn_mfma_f32_16x16x32_bf16(Bt[n][k], At[m][k], acc[ai][bj][m][n], 0, 0, 0); __builtin_amdgcn_s_setprio(0); } while (0)
#define PG8_WAIT_V(n) asm volatile("s_waitcnt vmcnt(" #n ")" ::: "memory")
#define PG8_WAIT_L(n) asm volatile("s_waitcnt lgkmcnt(" #n ")" ::: "memory")
#define PG8_BAR __builtin_amdgcn_s_barrier()
#define PG8_SCHED __builtin_amdgcn_sched_barrier(0)
    Unit cur, nxt; int ui = 0;
    if (!S.next(0, cur)) return;
    f32x4 acc[2][2][4][2];
#pragma unroll
    for (int a = 0; a < 2; ++a)
#pragma unroll
        for (int b = 0; b < 2; ++b)
#pragma unroll
            for (int m = 0; m < 4; ++m)
#pragma unroll
                for (int n = 0; n < 2; ++n) acc[a][b][m][n] = (f32x4){0.f, 0.f, 0.f, 0.f};
    bf16x8 At[4][2], B0[2][2], B1[2][2];
    const char* cA = (const char*)g.A + (size_t)cur.pm * tstep; const char* cB = (const char*)g.Bt + (size_t)cur.pn * tstep;
    S.a_ready(cur);
    if constexpr (SP2) {
        PG8_STAGE(PG8_SB(0, 0), cB, voffB); PG8_STAGE(PG8_SB(0, 1), cB + hstep, voffB); PG8_STAGE(PG8_SA(0, 0), cA, voffA); PG8_STAGE(PG8_SA(0, 1), cA + hstep, voffA);
        if (wr == 1) PG8_BAR;
        PG8_WAIT_V(2); PG8_BAR;
        PG8_STAGE(PG8_SB(1, 0), cB + kstep, voffB); PG8_STAGE(PG8_SA(1, 0), cA + kstep, voffA); PG8_STAGE(PG8_SB(1, 1), cB + hstep + kstep, voffB);
        PG8_WAIT_V(6); PG8_BAR;
    } else {
        PG8_STAGE(PG8_SB(0, 0), cB, voffB); PG8_STAGE(PG8_SA(0, 0), cA, voffA); PG8_STAGE(PG8_SB(0, 1), cB + hstep, voffB); PG8_STAGE(PG8_SA(0, 1), cA + hstep, voffA);
        if (wr == 1) PG8_BAR;
        PG8_WAIT_V(4); PG8_BAR;
        PG8_STAGE(PG8_SB(1, 0), cB + kstep, voffB); PG8_STAGE(PG8_SA(1, 0), cA + kstep, voffA); PG8_STAGE(PG8_SB(1, 1), cB + hstep + kstep, voffB);
        PG8_WAIT_V(6); PG8_BAR;
    }
    for (;;) {
        const bool has_next = S.next(ui + 1, nxt);
        const char* nA = has_next ? (const char*)g.A + (size_t)nxt.pm * tstep : cA; const char* nB = has_next ? (const char*)g.Bt + (size_t)nxt.pn * tstep : cB;
        for (int t = 0; t < nt; t += 2) {
            const bool last = (t == nt - 2);
            const char* a1 = cA + (size_t)(t + 1) * kstep;
            const char* a2 = last ? nA : cA + (size_t)(t + 2) * kstep; const char* b2 = last ? nB : cB + (size_t)(t + 2) * kstep;
            const char* a3 = a2 + kstep; const char* b3 = b2 + kstep;
            if (last && has_next) S.a_ready(nxt);
            if constexpr (SP2) {
            PG8_LDB(B0, 0, 0); PG8_LDB(B1, 0, 1); PG8_SCHED; PG8_LDA(At, 0, 0); PG8_STAGE(PG8_SA(1, 1), a1 + hstep, voffA);
            PG8_WAIT_V(8); PG8_WAIT_L(0); PG8_BAR; PG8_MMA(0, 0, At, B0); PG8_MMA(0, 1, At, B1); PG8_BAR; PG8_SCHED;
            PG8_LDA(At, 0, 1); PG8_STAGE(PG8_SB(0, 0), b2, voffB); PG8_STAGE(PG8_SB(0, 1), b2 + hstep, voffB); PG8_STAGE(PG8_SA(0, 0), a2, voffA);
            PG8_WAIT_V(8); PG8_WAIT_L(0); PG8_BAR; PG8_MMA(1, 0, At, B0); PG8_MMA(1, 1, At, B1); PG8_BAR; PG8_SCHED;
            PG8_LDB(B0, 1, 0); PG8_LDB(B1, 1, 1); PG8_SCHED; PG8_LDA(At, 1, 0); PG8_STAGE(PG8_SA(0, 1), a2 + hstep, voffA);
            PG8_WAIT_V(8); PG8_WAIT_L(0); PG8_BAR; PG8_MMA(0, 0, At, B0); PG8_MMA(0, 1, At, B1); PG8_BAR; PG8_SCHED;
            PG8_LDA(At, 1, 1); PG8_STAGE(PG8_SB(1, 0), b3, voffB); PG8_STAGE(PG8_SB(1, 1), b3 + hstep, voffB); PG8_STAGE(PG8_SA(1, 0), a3, voffA);
            PG8_WAIT_V(8); PG8_WAIT_L(0); PG8_BAR; PG8_MMA(1, 0, At, B0); PG8_MMA(1, 1, At, B1); PG8_BAR; PG8_SCHED;
            } else {
            PG8_LDB(B0, 0, 0); PG8_SCHED; PG8_LDA(At, 0, 0); PG8_STAGE(PG8_SA(1, 1), a1 + hstep, voffA);
            PG8_WAIT_L(8); PG8_BAR; PG8_WAIT_L(0); PG8_MMA(0, 0, At, B0); PG8_BAR; PG8_SCHED;
            PG8_LDB(B1, 0, 1); PG8_STAGE(PG8_SB(0, 0), b2, voffB);
            PG8_BAR; PG8_WAIT_L(0); PG8_MMA(0, 1, At, B1); PG8_BAR;
            PG8_LDA(At, 0, 1); PG8_STAGE(PG8_SA(0, 0), a2, voffA);
            PG8_BAR; PG8_WAIT_L(0); PG8_MMA(1, 0, At, B0); PG8_BAR; PG8_SCHED;
            PG8_STAGE(PG8_SB(0, 1), b2 + hstep, voffB);
            PG8_WAIT_V(6); PG8_BAR; PG8_MMA(1, 1, At, B1); PG8_BAR;
            PG8_LDB(B0, 1, 0); PG8_SCHED; PG8_LDA(At, 1, 0); PG8_STAGE(PG8_SA(0, 1), a2 + hstep, voffA);
            PG8_WAIT_L(8); PG8_BAR; PG8_WAIT_L(0); PG8_MMA(0, 0, At, B0); PG8_BAR; PG8_SCHED;
            PG8_LDB(B1, 1, 1); PG8_STAGE(PG8_SB(1, 0), b3, voffB);
            PG8_BAR; PG8_WAIT_L(0); PG8_MMA(0, 1, At, B1); PG8_BAR;
            PG8_LDA(At, 1, 1); PG8_STAGE(PG8_SA(1, 0), a3, voffA);
            PG8_BAR; PG8_WAIT_L(0); PG8_MMA(1, 0, At, B0); PG8_BAR; PG8_SCHED;
            PG8_STAGE(PG8_SB(1, 1), b3 + hstep, voffB);
            PG8_WAIT_V(6); PG8_BAR; PG8_MMA(1, 1, At, B1); PG8_BAR;
            }
        }
        if constexpr (ALIGN_EPI) { if (wr == 0) PG8_BAR; }
        if constexpr (!Epi::AFTER_DRAIN) { E(acc, cur, wr, wc, fr, fq); S.done(cur); }
        if (!has_next) break;
#pragma unroll
        for (int a = 0; a < 2; ++a)
#pragma unroll
            for (int b = 0; b < 2; ++b)
#pragma unroll
                for (int m = 0; m < 4; ++m)
#pragma unroll
                    for (int n = 0; n < 2; ++n) acc[a][b][m][n] = (f32x4){0.f, 0.f, 0.f, 0.f};
        cur = nxt; cA = nA; cB = nB; ++ui;
        if constexpr (ALIGN_EPI) { if (wr == 1) PG8_BAR; }
    }
    PG8_WAIT_V(0);
    if constexpr (!ALIGN_EPI) { if (wr == 0) PG8_BAR; }
    PG8_BAR;
    if constexpr (Epi::AFTER_DRAIN) { E.fused(acc, cur, wr, wc, fr, fq, lds, wid, lane); S.done(cur); }
#undef PG8_SA
#undef PG8_SB
#undef PG8_STAGE
#undef PG8_LDA
#undef PG8_LDB
#undef PG8_MMA
#undef PG8_WAIT_V
#undef PG8_WAIT_L
#undef PG8_BAR
#undef PG8_SCHED
}
}

#ifndef MK_SINGLE
#define MK_SINGLE 1
#endif
constexpr int NWAVES = 8;
constexpr int M = 16384, D = 1024, INW = 3328, FF = 4096, SEQ = 8192, NH = 6, HD = 128, PW = 256, DEPTH = 4, HW = 768;
constexpr int SEGL = 512, NSEG = SEQ / SEGL, NCH = SEGL / 64, NHITEMS = 2 * NH * NSEG;
constexpr int NPOOL = M / 256;
constexpr float EPS = 1e-5f;
constexpr int NPHASES = 2 + 6 * DEPTH;
constexpr size_t MiB = 1u << 20;
constexpr size_t WS_BAR = 0, BAR_ZERO_BYTES = 16384;
constexpr size_t WS_LB = 1 * MiB;
constexpr size_t WS_WIN = 2 * MiB, WS_WOUT = 9 * MiB, WS_WUP = 11 * MiB, WS_WDN = 19 * MiB;
constexpr size_t WS_XB = 27 * MiB, WS_Y = 59 * MiB;
constexpr size_t WS_SEGS = 91 * MiB, WS_SEGD = 103 * MiB;
constexpr size_t WS_U = 104 * MiB;
constexpr size_t WS_SS = 232 * MiB;
constexpr size_t WS_END = 241 * MiB;
static_assert(WS_SS + 9 * (size_t)M * 64 <= WS_END && WS_WIN + (size_t)INW * D * 2 <= WS_WOUT && WS_SEGS + (size_t)NHITEMS * 65536 <= WS_SEGD && WS_U + (size_t)M * FF * 2 <= WS_SS, "ws map");
constexpr int LDS_BYTES = 147456;
constexpr int MISC_OFF = 131072;
constexpr int QP = 136, SP = 72, OP = 132;
constexpr int Q_OFF = 0, KT_OFF = 17408, OB_OFF = 0  , KH_OFF = 34816, VT_OFF = 53248, ST_OFF = 71680, PM_OFF = 106496, TOT_OFF = 115712, DV_OFF = 119808, DS_OFF = 120320;
static_assert(64 * OP * 4 <= KH_OFF && DS_OFF + 512 <= 131072, "mixer LDS map");
constexpr int PPP = 264;
constexpr int PP_OFF = 0, WT_OFF = 128 * PPP * 2;
static_assert(WT_OFF + 256 * SP * 2 <= 131072, "pool LDS map");

#define LAS __attribute__((address_space(3)))
typedef unsigned short bf16;
typedef float f32x4 __attribute__((ext_vector_type(4)));
typedef float f32x2 __attribute__((ext_vector_type(2)));
typedef short bf16x8 __attribute__((ext_vector_type(8)));
typedef unsigned u32x4 __attribute__((ext_vector_type(4)));
typedef unsigned u32x2 __attribute__((ext_vector_type(2)));
typedef __bf16 bf16x2_t __attribute__((ext_vector_type(2)));
__device__ __forceinline__ unsigned pk2(float lo, float hi) { f32x2 v = {lo, hi}; bf16x2_t b = __builtin_convertvector(v, bf16x2_t); return __builtin_bit_cast(unsigned, b); }
__device__ __forceinline__ float bflo(unsigned u) { return __uint_as_float(u << 16); }
__device__ __forceinline__ float bfhi(unsigned u) { return __uint_as_float(u & 0xffff0000u); }
__device__ __forceinline__ float wave_sum(float v) {
#pragma unroll
    for (int o = 1; o < 64; o <<= 1) v += __shfl_xor(v, o);
    return v;
}
#define MFMA16(a, b, c) __builtin_amdgcn_mfma_f32_16x16x32_bf16((a), (b), (c), 0, 0, 0)

__device__ __forceinline__ void transpose_item(const float* W, const float* g, int K, int N, bf16* WT, LAS float* scr, int item, int lane) {
    const int nblk = N / 32, kb = item / nblk, nb = item % nblk, k0 = 64 * kb, n0 = 32 * nb;
#pragma unroll 8
    for (int i = 0; i < 32; ++i) { const int kk = 2 * i + (lane >> 5); float v = W[(size_t)(k0 + kk) * N + n0 + (lane & 31)]; if (g) v *= g[k0 + kk]; scr[kk * 33 + (lane & 31)] = v; }
    asm volatile("s_waitcnt lgkmcnt(0)" ::: "memory");
    const int c = lane & 7;
#pragma unroll
    for (int j = 0; j < 4; ++j) { const int n = (lane >> 3) + 8 * j; const LAS float* s = scr + (8 * c) * 33 + n;
        u32x4 o; o.x = pk2(s[0 * 33], s[1 * 33]); o.y = pk2(s[2 * 33], s[3 * 33]); o.z = pk2(s[4 * 33], s[5 * 33]); o.w = pk2(s[6 * 33], s[7 * 33]);
        *(u32x4*)(WT + (size_t)(n0 + n) * K + k0 + 8 * c) = o; }
    asm volatile("s_waitcnt lgkmcnt(0)" ::: "memory");
}
__device__ __forceinline__ int convert_one(LAS unsigned char* lds, const float* W, const float* g, bf16* WT, int K, int N, int base, int gw, int ngw, int wave, int lane) {
    LAS float* scr = (LAS float*)(lds + wave * 16384);
    const int nit = (K / 64) * (N / 32);
    int it = (gw - base % ngw + ngw) % ngw;
    for (; it < nit; it += ngw) transpose_item(W, g, K, N, WT, scr, it, lane);
    return base + nit;
}

#define XB_TMO      128
#define XB_XCNT(j)  (256  + 64 * (j))
#define XB_XSUB(j)  (1280 + 64 * (j))
#define XB_XGEN(j)  (2304 + 64 * (j))
#define XB_TOP      3328
#define XB_TOPGEN   3392
#define XCD_BAR_WORDS 3456
#define XB_SPIN_CAP (1u << 18)

__device__ __forceinline__ unsigned xb_ld(unsigned* p)              { return __hip_atomic_load(p, __ATOMIC_RELAXED, __HIP_MEMORY_SCOPE_AGENT); }
__device__ __forceinline__ unsigned xb_add(unsigned* p, unsigned v) { return __hip_atomic_fetch_add(p, v, __ATOMIC_RELAXED, __HIP_MEMORY_SCOPE_AGENT); }
__device__ __forceinline__ unsigned xb_xcc_id() { return (unsigned)__builtin_amdgcn_s_getreg((3 << 11) | 20) & 0xFu; }
#define XB_SPIN(cond, bar) do { unsigned _sp = 0; while (cond) { __builtin_amdgcn_s_sleep(1); \
    if ((++_sp & 255u) == 0u) { if (xb_ld(&(bar)[XB_TMO])) break; if (_sp > XB_SPIN_CAP) { atomicAdd(&(bar)[XB_TMO], 1u); break; } } } } while (0)

struct XcdBarrier {
    unsigned* bar; unsigned x;
    volatile LAS unsigned* st;
};

__device__ __forceinline__ XcdBarrier xcd_barrier_post(unsigned* bar, volatile LAS unsigned* st) {
    XcdBarrier b; b.bar = bar; b.x = xb_xcc_id(); b.st = st;
    if (threadIdx.x == 0) (void)xb_add(&bar[XB_XCNT(b.x)], 1u);
    return b;
}
__device__ __forceinline__ void xcd_barrier_complete(unsigned* bar, unsigned x, unsigned& nloc, unsigned& nx) {
    const unsigned G = gridDim.x * gridDim.y * gridDim.z;
    unsigned sum, cnt, mine, sp = 0u;
    for (;;) {
        sum = 0u; cnt = 0u; mine = 0u;
#pragma unroll
        for (unsigned j = 0; j < 16; ++j) { const unsigned c = xb_ld(&bar[XB_XCNT(j)]); sum += c; cnt += (c > 0u) ? 1u : 0u; mine = (j == x) ? c : mine; }
        if (sum == G) break;
        __builtin_amdgcn_s_sleep(1);
        if ((++sp & 255u) == 0u) { if (xb_ld(&bar[XB_TMO])) break; if (sp > XB_SPIN_CAP) { atomicAdd(&bar[XB_TMO], 1u); break; } }
    }
    nloc = mine > 0u ? mine : 1u; nx = cnt > 0u ? cnt : 1u;
}

__device__ __forceinline__ void xcd_barrier(const XcdBarrier& b) {
    asm volatile("s_waitcnt vmcnt(0)" ::: "memory");
    __syncthreads();
    if (threadIdx.x == 0) {
        unsigned* bar = b.bar;
        __builtin_amdgcn_s_waitcnt(0);
        unsigned nloc = b.st[0], nx = b.st[1];
        if (nloc == 0u) { xcd_barrier_complete(bar, b.x, nloc, nx); b.st[0] = nloc; b.st[1] = nx; }
        const unsigned old = xb_add(&bar[XB_XSUB(b.x)], 1u);
        const unsigned gen = old / nloc;
        if (old + 1u == (gen + 1u) * nloc) {
            __builtin_amdgcn_fence(__ATOMIC_RELEASE, "agent");
            asm volatile("s_waitcnt vmcnt(0)" ::: "memory");
            const unsigned og = xb_add(&bar[XB_TOP], 1u);
            const unsigned tg = og / nx;
            if (og + 1u == (tg + 1u) * nx) xb_add(&bar[XB_TOPGEN], 1u);
            else XB_SPIN(xb_ld(&bar[XB_TOPGEN]) == tg, bar);
            __builtin_amdgcn_fence(__ATOMIC_ACQUIRE, "agent");
            xb_add(&bar[XB_XGEN(b.x)], 1u);
            asm volatile("s_waitcnt vmcnt(0)" ::: "memory");
        } else {
            XB_SPIN(xb_ld(&bar[XB_XGEN(b.x)]) == gen, bar);
            __builtin_amdgcn_fence(__ATOMIC_ACQUIRE, "agent");
            asm volatile("s_waitcnt vmcnt(0)" ::: "memory");
        }
    }
    __syncthreads();
}

template <bool FULL>
__device__ __forceinline__ void hgrn_item(LAS unsigned char* lds, const bf16* U, bf16* Y, float* SEGS, float* SEGD, const float* normg, int item, int tid) {
    const int lane = tid & 63, w = __builtin_amdgcn_readfirstlane(tid >> 6), fr = lane & 15, fq = lane >> 4;
    const int j = item % NSEG, bh = item / NSEG, h = bh % NH, b = bh / NH;
    if (!FULL && j == NSEG - 1) return;
    const int row0 = b * SEQ + j * SEGL;
    LAS bf16* Qs = (LAS bf16*)(lds + Q_OFF); LAS bf16* KT = (LAS bf16*)(lds + KT_OFF); LAS bf16* KH = (LAS bf16*)(lds + KH_OFF); LAS bf16* VT = (LAS bf16*)(lds + VT_OFF);
    LAS bf16* ST = (LAS bf16*)(lds + ST_OFF); LAS bf16* PM = (LAS bf16*)(lds + PM_OFF); LAS float* OB = (LAS float*)(lds + OB_OFF);
    LAS float* TOT = (LAS float*)(lds + TOT_OFF); LAS float* DV = (LAS float*)(lds + DV_OFF); LAS float* DS = (LAS float*)(lds + DS_OFF);
    f32x4 S[8];
#pragma unroll
    for (int vt = 0; vt < 8; ++vt) S[vt] = (f32x4){0.f, 0.f, 0.f, 0.f};
    if (tid < 128) DS[tid] = 0.f;
    if (FULL) {
        for (int i = 0; i < j; ++i) {
            const float* Ki = SEGS + (size_t)(bh * NSEG + i) * 16384; const f32x4 dv = *(const f32x4*)(SEGD + (size_t)(bh * NSEG + i) * 128 + 16 * w + 4 * fq);
#pragma unroll
            for (int vt = 0; vt < 8; ++vt) { const f32x4 kv = *(const f32x4*)(Ki + (size_t)((vt * 8 + w) * 64 + lane) * 4); S[vt] = S[vt] * dv + kv; }
        }
#pragma unroll
        for (int vt = 0; vt < 8; ++vt) { u32x2 o; o.x = pk2(S[vt][0], S[vt][1]); o.y = pk2(S[vt][2], S[vt][3]); *(LAS u32x2*)(ST + (16 * vt + fr) * QP + 16 * w + 4 * fq) = o; }
    }
    __syncthreads();
    for (int c = 0; c < NCH; ++c) {
        const int r0 = row0 + c * 64;
        const bf16* up = U + (size_t)(r0 + 8 * w) * INW + h * HD + 2 * lane;
        unsigned lf2[8], v2[8], q2[8];
#pragma unroll
        for (int jj = 0; jj < 8; ++jj) { lf2[jj] = *(const unsigned*)(up + (size_t)jj * INW + 1024); v2[jj] = *(const unsigned*)(up + (size_t)jj * INW + 1792); q2[jj] = FULL ? *(const unsigned*)(up + (size_t)jj * INW + 256) : 0u; }
        float bl0[8], bl1[8]; float a0 = 0.f, a1 = 0.f;
#pragma unroll
        for (int jj = 0; jj < 8; ++jj) { a0 += bflo(lf2[jj]); a1 += bfhi(lf2[jj]); bl0[jj] = a0; bl1[jj] = a1; }
        *(LAS f32x2*)(TOT + w * 128 + 2 * lane) = (f32x2){a0, a1};
        __syncthreads();
        float p0 = 0.f, p1 = 0.f, t0 = 0.f, t1 = 0.f;
#pragma unroll
        for (int g = 0; g < 8; ++g) { const f32x2 tv = *(const LAS f32x2*)(TOT + g * 128 + 2 * lane); if (g < w) { p0 += tv.x; p1 += tv.y; } t0 += tv.x; t1 += tv.y; }
        if (w == 0) { *(LAS f32x2*)(DV + 2 * lane) = (f32x2){__expf(t0), __expf(t1)}; const f32x2 ds = *(const LAS f32x2*)(DS + 2 * lane); *(LAS f32x2*)(DS + 2 * lane) = (f32x2){ds.x + t0, ds.y + t1}; }
        float kh0[8], kh1[8];
#pragma unroll
        for (int jj = 0; jj < 8; ++jj) {
            const float b0 = p0 + bl0[jj], b1 = p1 + bl1[jj];
            const float k0 = 1.0f - __expf(bflo(lf2[jj])), k1 = 1.0f - __expf(bfhi(lf2[jj]));
            kh0[jj] = k0 * __expf(t0 - b0); kh1[jj] = k1 * __expf(t1 - b1);
            if (FULL) {
                const float bc0 = fmaxf(b0, -80.f), bc1 = fmaxf(b1, -80.f);
                const float e0 = __expf(bc0), e1 = __expf(bc1), i0 = __expf(-bc0), i1 = __expf(-bc1);
                *(LAS unsigned*)(Qs + (8 * w + jj) * QP + 2 * lane) = pk2(bflo(q2[jj]) * e0, bfhi(q2[jj]) * e1);
                *(LAS unsigned*)(KT + (8 * w + jj) * QP + 2 * lane) = pk2(k0 * i0, k1 * i1);
            }
        }
        { u32x4 o; o.x = pk2(kh0[0], kh0[1]); o.y = pk2(kh0[2], kh0[3]); o.z = pk2(kh0[4], kh0[5]); o.w = pk2(kh0[6], kh0[7]); *(LAS u32x4*)(KH + (2 * lane) * SP + 8 * w) = o;
          o.x = pk2(kh1[0], kh1[1]); o.y = pk2(kh1[2], kh1[3]); o.z = pk2(kh1[4], kh1[5]); o.w = pk2(kh1[6], kh1[7]); *(LAS u32x4*)(KH + (2 * lane + 1) * SP + 8 * w) = o;
          o.x = (v2[0] & 0xffffu) | (v2[1] << 16); o.y = (v2[2] & 0xffffu) | (v2[3] << 16); o.z = (v2[4] & 0xffffu) | (v2[5] << 16); o.w = (v2[6] & 0xffffu) | (v2[7] << 16); *(LAS u32x4*)(VT + (2 * lane) * SP + 8 * w) = o;
          o.x = (v2[0] >> 16) | (v2[1] & 0xffff0000u); o.y = (v2[2] >> 16) | (v2[3] & 0xffff0000u); o.z = (v2[4] >> 16) | (v2[5] & 0xffff0000u); o.w = (v2[6] >> 16) | (v2[7] & 0xffff0000u); *(LAS u32x4*)(VT + (2 * lane + 1) * SP + 8 * w) = o; }
        __syncthreads();
        const int tt = w >> 1;
        f32x4 oa[4];
        if constexpr (FULL) {
#pragma unroll
            for (int ti = 0; ti < 2; ++ti) { const int ts = (w & 1) * 2 + ti; f32x4 pa = (f32x4){0.f, 0.f, 0.f, 0.f};
                if (ts <= tt) {
#pragma unroll
                    for (int kk = 0; kk < 4; ++kk) { const bf16x8 a = *(const LAS bf16x8*)(KT + (ts * 16 + fr) * QP + kk * 32 + 8 * fq); const bf16x8 bq = *(const LAS bf16x8*)(Qs + (tt * 16 + fr) * QP + kk * 32 + 8 * fq); pa = MFMA16(a, bq, pa); }
                    if (ts == tt) {
#pragma unroll
                        for (int i = 0; i < 4; ++i) if (4 * fq + i > fr) pa[i] = 0.f;
                    }
                }
                u32x2 o; o.x = pk2(pa[0], pa[1]); o.y = pk2(pa[2], pa[3]); *(LAS u32x2*)(PM + (tt * 16 + fr) * SP + ts * 16 + 4 * fq) = o; }
            bf16x8 qf[4];
#pragma unroll
            for (int kk = 0; kk < 4; ++kk) qf[kk] = *(const LAS bf16x8*)(Qs + (tt * 16 + fr) * QP + kk * 32 + 8 * fq);
#pragma unroll
            for (int vi = 0; vi < 4; ++vi) { const int vt = (w & 1) * 4 + vi; oa[vi] = (f32x4){0.f, 0.f, 0.f, 0.f};
#pragma unroll
                for (int kk = 0; kk < 4; ++kk) { const bf16x8 sf = *(const LAS bf16x8*)(ST + (vt * 16 + fr) * QP + kk * 32 + 8 * fq); oa[vi] = MFMA16(sf, qf[kk], oa[vi]); } }
            __syncthreads();
            bf16x8 pf[2];
#pragma unroll
            for (int kk = 0; kk < 2; ++kk) pf[kk] = *(const LAS bf16x8*)(PM + (tt * 16 + fr) * SP + kk * 32 + 8 * fq);
#pragma unroll
            for (int vi = 0; vi < 4; ++vi) { const int vt = (w & 1) * 4 + vi;
#pragma unroll
                for (int kk = 0; kk < 2; ++kk) { const bf16x8 vf = *(const LAS bf16x8*)(VT + (vt * 16 + fr) * SP + kk * 32 + 8 * fq); oa[vi] = MFMA16(vf, pf[kk], oa[vi]); } }
        }
        { const f32x4 dv = *(const LAS f32x4*)(DV + 16 * w + 4 * fq); bf16x8 kf[2];
#pragma unroll
          for (int kk = 0; kk < 2; ++kk) kf[kk] = *(const LAS bf16x8*)(KH + (16 * w + fr) * SP + kk * 32 + 8 * fq);
#pragma unroll
          for (int vt = 0; vt < 8; ++vt) { S[vt] = S[vt] * dv;
#pragma unroll
              for (int kk = 0; kk < 2; ++kk) { const bf16x8 vf = *(const LAS bf16x8*)(VT + (vt * 16 + fr) * SP + kk * 32 + 8 * fq); S[vt] = MFMA16(kf[kk], vf, S[vt]); } } }
        if constexpr (FULL) {
            __syncthreads();
#pragma unroll
            for (int vt = 0; vt < 8; ++vt) { u32x2 o; o.x = pk2(S[vt][0], S[vt][1]); o.y = pk2(S[vt][2], S[vt][3]); *(LAS u32x2*)(ST + (16 * vt + fr) * QP + 16 * w + 4 * fq) = o; }
#pragma unroll
            for (int vi = 0; vi < 4; ++vi) { const int vt = (w & 1) * 4 + vi; *(LAS f32x4*)(OB + (tt * 16 + fr) * OP + vt * 16 + 4 * fq) = oa[vi]; }
            __syncthreads();
            const int t = tid >> 3, vs = (tid & 7) * 16;
            f32x4 o4[4]; float ssq = 0.f;
#pragma unroll
            for (int q = 0; q < 4; ++q) { o4[q] = *(const LAS f32x4*)(OB + t * OP + vs + 4 * q); ssq += (o4[q][0] * o4[q][0] + o4[q][1] * o4[q][1]) + (o4[q][2] * o4[q][2] + o4[q][3] * o4[q][3]); }
            ssq += __shfl_xor(ssq, 1); ssq += __shfl_xor(ssq, 2); ssq += __shfl_xor(ssq, 4);
            const float rs = rsqrtf(ssq * (1.0f / 128.0f) + EPS);
            const bf16* gp = U + (size_t)(r0 + t) * INW + 2560 + h * HD + vs;
            const u32x4 g0 = *(const u32x4*)gp, g1 = *(const u32x4*)(gp + 8);
            const float* ng = normg + h * HD + vs;
            const f32x4 n0 = *(const f32x4*)ng, n1 = *(const f32x4*)(ng + 4), n2 = *(const f32x4*)(ng + 8), n3 = *(const f32x4*)(ng + 12);
            u32x4 y0, y1;
            y0.x = pk2(o4[0][0] * rs * n0[0] * bflo(g0.x), o4[0][1] * rs * n0[1] * bfhi(g0.x)); y0.y = pk2(o4[0][2] * rs * n0[2] * bflo(g0.y), o4[0][3] * rs * n0[3] * bfhi(g0.y));
            y0.z = pk2(o4[1][0] * rs * n1[0] * bflo(g0.z), o4[1][1] * rs * n1[1] * bfhi(g0.z)); y0.w = pk2(o4[1][2] * rs * n1[2] * bflo(g0.w), o4[1][3] * rs * n1[3] * bfhi(g0.w));
            y1.x = pk2(o4[2][0] * rs * n2[0] * bflo(g1.x), o4[2][1] * rs * n2[1] * bfhi(g1.x)); y1.y = pk2(o4[2][2] * rs * n2[2] * bflo(g1.y), o4[2][3] * rs * n2[3] * bfhi(g1.y));
            y1.z = pk2(o4[3][0] * rs * n3[0] * bflo(g1.z), o4[3][1] * rs * n3[1] * bfhi(g1.z)); y1.w = pk2(o4[3][2] * rs * n3[2] * bflo(g1.w), o4[3][3] * rs * n3[3] * bfhi(g1.w));
            bf16* yp = Y + (size_t)(r0 + t) * D + PW + h * HD + vs;
            *(u32x4*)yp = y0; *(u32x4*)(yp + 8) = y1;
        }
    }
    if (!FULL) {
#pragma unroll
        for (int vt = 0; vt < 8; ++vt) *(f32x4*)(SEGS + (size_t)item * 16384 + (size_t)((vt * 8 + w) * 64 + lane) * 4) = S[vt];
        if (tid < 128) SEGD[(size_t)item * 128 + tid] = __expf(DS[tid]);
    }
    __syncthreads();
}

template <int WIN>
__device__ __forceinline__ void pool_run(LAS bf16* PP, const bf16* U, int R, int tl0, int g, int pair) {
    const bf16* up = U + (size_t)R * INW + g * 64 + 2 * pair; const int tseq0 = R % SEQ;
    unsigned xv[16 + WIN - 1];
#pragma unroll
    for (int i = 0; i < 16 + WIN - 1; ++i) { const int tt = i - (WIN - 1); xv[i] = (tseq0 + tt >= 0) ? *(const unsigned*)(up + (long)tt * INW) : 0u; }
    float s0 = 0.f, s1 = 0.f;
#pragma unroll
    for (int i = 0; i < WIN - 1; ++i) { s0 += bflo(xv[i]); s1 += bfhi(xv[i]); }
#pragma unroll
    for (int jj = 0; jj < 16; ++jj) { const float x0 = bflo(xv[jj + WIN - 1]), x1 = bfhi(xv[jj + WIN - 1]); s0 += x0; s1 += x1;
        const int cn = tseq0 + jj + 1; const float ic = 1.0f / (float)(cn < WIN ? cn : WIN);
        *(LAS unsigned*)(PP + (tl0 + jj) * PPP + g * 64 + 2 * pair) = pk2(s0 * ic - x0, s1 * ic - x1);
        s0 -= bflo(xv[jj]); s1 -= bfhi(xv[jj]); }
}
__device__ __forceinline__ void pool_item(LAS unsigned char* lds, const bf16* U, bf16* Y, const float* poolw, const float* pscale, int item, int tid) {
    const int lane = tid & 63, w = __builtin_amdgcn_readfirstlane(tid >> 6), fr = lane & 15, fq = lane >> 4;
    LAS bf16* PP = (LAS bf16*)(lds + PP_OFF); LAS bf16* WT = (LAS bf16*)(lds + WT_OFF);
    for (int i = 0; i < 32; ++i) { const int idx = tid + 512 * i; const int g = idx >> 12, c = (idx >> 6) & 63, d = idx & 63; WT[(g * 64 + d) * SP + c] = (bf16)(pk2(poolw[idx], 0.f) & 0xffffu); }
    for (int hh = 0; hh < 2; ++hh) {
        const int R0 = item * 256 + hh * 128;
#pragma unroll 1
        for (int rr = 0; rr < 2; ++rr) { const int g = w & 3, tq = w >> 2, pair = lane & 31, sub = lane >> 5, tl0 = tq * 64 + sub * 32 + rr * 16;
          if (g == 0) pool_run<2>(PP, U, R0 + tl0, tl0, 0, pair); else if (g == 1) pool_run<4>(PP, U, R0 + tl0, tl0, 1, pair); else if (g == 2) pool_run<8>(PP, U, R0 + tl0, tl0, 2, pair); else pool_run<16>(PP, U, R0 + tl0, tl0, 3, pair); }
        __syncthreads();
#pragma unroll 1
        for (int g = 0; g < 4; ++g) { bf16x8 pf[2];
#pragma unroll
            for (int kk = 0; kk < 2; ++kk) pf[kk] = *(const LAS bf16x8*)(PP + (16 * w + fr) * PPP + g * 64 + kk * 32 + 8 * fq);
#pragma unroll
            for (int dt = 0; dt < 4; ++dt) { f32x4 acc = (f32x4){0.f, 0.f, 0.f, 0.f};
#pragma unroll
                for (int kk = 0; kk < 2; ++kk) { const bf16x8 wf = *(const LAS bf16x8*)(WT + (g * 64 + dt * 16 + fr) * SP + kk * 32 + 8 * fq); acc = MFMA16(wf, pf[kk], acc); }
                const int dcol = g * 64 + dt * 16 + 4 * fq; const f32x4 sc = *(const f32x4*)(pscale + dcol);
                u32x2 o; o.x = pk2(acc[0] * sc[0], acc[1] * sc[1]); o.y = pk2(acc[2] * sc[2], acc[3] * sc[3]);
                *(u32x2*)(Y + (size_t)(R0 + 16 * w + fr) * D + dcol) = o; } }
        __syncthreads();
    }
}

struct Args { const float* in[12]; float* out; unsigned char* ws; int ph_lo, ph_hi; };
static_assert(sizeof(Args) == 12 * 8 + 8 + 8 + 8, "Args has no padding");

__global__ void __launch_bounds__(NWAVES * 64, 2) mk_fwd(Args args) {
    extern __shared__ __attribute__((aligned(16))) unsigned char lds_raw[];
    LAS unsigned char* lds = (LAS unsigned char*)lds_raw;
    const int tid = threadIdx.x, lane = tid & 63, wave = __builtin_amdgcn_readfirstlane(tid >> 6);
    const int G = gridDim.x, bx = blockIdx.x, gw = bx * NWAVES + wave, ngw = G * NWAVES;
    unsigned char* ws = args.ws;
    float* X = args.out;
#define INPTRS(A) const float* norm_mix_g = (A).in[1]; const float* w_in = (A).in[2]; const float* pool_w = (A).in[3]; const float* pool_scale = (A).in[4]; \
    const float* hgrn_norm_g = (A).in[6]; const float* w_out = (A).in[7]; const float* norm_mlp_g = (A).in[8]; const float* w_up = (A).in[9]; const float* w_down = (A).in[10];
#define WSPTRS(wsb) bf16* WIN = (bf16*)((wsb) + WS_WIN); bf16* WOUT = (bf16*)((wsb) + WS_WOUT); bf16* WUP = (bf16*)((wsb) + WS_WUP); bf16* WDN = (bf16*)((wsb) + WS_WDN); \
    bf16* XB = (bf16*)((wsb) + WS_XB); bf16* Yb = (bf16*)((wsb) + WS_Y); bf16* U = (bf16*)((wsb) + WS_U); bf16* Hb = (bf16*)((wsb) + WS_U); \
    float* SEGS = (float*)((wsb) + WS_SEGS); float* SEGD = (float*)((wsb) + WS_SEGD); float* SS = (float*)((wsb) + WS_SS); float* LB = (float*)((wsb) + WS_LB);
    const int lo = args.ph_lo, hi = args.ph_hi;
#if MK_SINGLE
    cg::grid_group grid = cg::this_grid();
    volatile LAS unsigned* MISC = (volatile LAS unsigned*)(lds + MISC_OFF);
    if (tid < 32) MISC[tid] = 0u;
    __syncthreads();
    (void)xcd_barrier_post((unsigned*)(ws + WS_BAR), MISC);
#define SEAM(k) do { if ((k) + 1 < hi) { if ((k) == 0) grid.sync(); else { XcdBarrier xb_; xb_.bar = (unsigned*)(args.ws + WS_BAR); xb_.x = xb_xcc_id(); xb_.st = (volatile LAS unsigned*)(lds + MISC_OFF); xcd_barrier(xb_); } } } while (0)
#else
#define SEAM(k) do { } while (0)
#endif
#define IN(k) (lo <= (k) && (k) < hi)

    if (IN(0)) {
        WSPTRS(ws)
        const float* x_in = args.in[0]; const float* norm_mix_g = args.in[1]; const float* w_in = args.in[2]; const float* lb_logits = args.in[5];
        if (bx == 0) for (int ch = tid; ch < HW; ch += NWAVES * 64) {
            float l0 = lb_logits[ch], l1 = lb_logits[HW + ch], l2 = lb_logits[2 * HW + ch], l3 = lb_logits[3 * HW + ch];
            const float mx = fmaxf(fmaxf(l0, l1), fmaxf(l2, l3)); l0 = expf(l0 - mx); l1 = expf(l1 - mx); l2 = expf(l2 - mx); l3 = expf(l3 - mx);
            const float inv = 1.0f / (l0 + l1 + l2 + l3);
            LB[ch] = 0.f; LB[HW + ch] = l1 * inv; LB[2 * HW + ch] = (l1 + l2) * inv; LB[3 * HW + ch] = (l1 + l2 + l3) * inv; }
        (void)convert_one(lds, w_in, norm_mix_g, WIN, D, INW, 0, gw, ngw, wave, lane);
        for (int m = gw; m < M; m += ngw) {
            const f32x4* xr = (const f32x4*)(x_in + (size_t)m * D) + lane; f32x4 v[4]; float s = 0.f;
#pragma unroll
            for (int j = 0; j < 4; ++j) { v[j] = xr[64 * j]; s += (v[j][0] * v[j][0] + v[j][1] * v[j][1]) + (v[j][2] * v[j][2] + v[j][3] * v[j][3]); }
            s = wave_sum(s);
            f32x4* xo = (f32x4*)(X + (size_t)m * D) + lane; u32x2* bo = (u32x2*)(XB + (size_t)m * D) + lane;
#pragma unroll
            for (int j = 0; j < 4; ++j) { xo[64 * j] = v[j]; u32x2 o; o.x = pk2(v[j][0], v[j][1]); o.y = pk2(v[j][2], v[j][3]); bo[64 * j] = o; }
            if (lane < 16) SS[(size_t)m * 16 + lane] = (lane == 0) ? s : 0.f;
        }
        SEAM(0);
    }
#pragma unroll 1
    for (int l = 0; l < DEPTH; ++l) {
        const int pb = 1 + 6 * l;
        int tid_l = threadIdx.x; asm volatile("" : "+v"(tid_l));
        unsigned char* ws_l = ws; asm volatile("" : "+s"(ws_l));
        const int lane_l = tid_l & 63, wave_l = __builtin_amdgcn_readfirstlane(tid_l >> 6), gw_l = bx * NWAVES + wave_l;
        WSPTRS(ws_l)
        const Args* ap = (const Args*)__builtin_amdgcn_kernarg_segment_ptr(); asm volatile("" : "+s"(ap));
        INPTRS(*ap)
        float* X = ap->out;
        if (IN(pb)) {
            pg8::Gemm g{XB, WIN, M, INW, D}; pg8::StaticOrder S; S.init(M, INW, G, bx);
#if defined(DBG_EXP) && DBG_EXP == 1
            pg8::EpiAct E{U, INW, SS + (size_t)(l == 3 ? 0 : 2 * l) * M * 16, LB + l * HW, 1};
#elif defined(DBG_EXP) && DBG_EXP == 2
            pg8::EpiAct E{U, INW, SS + (size_t)(2 * l) * M * 16, LB + (l == 3 ? 2 : l) * HW, 1};
#else
            pg8::EpiAct E{U, INW, SS + (size_t)(2 * l) * M * 16, LB + l * HW, 1};
#endif
            pg8::gemm_phase<pg8::EpiAct, pg8::StaticOrder, true, true>(lds, g, S, E);
            SEAM(pb);
        }
        if (IN(pb + 1)) {
            for (int it = bx; it < NHITEMS + NPOOL; it += G) {
                if (it < NHITEMS) hgrn_item<false>(lds, U, Yb, SEGS, SEGD, hgrn_norm_g + l * HW, it, tid_l);
                else pool_item(lds, U, Yb, pool_w + (size_t)l * 16384, pool_scale + l * PW, it - NHITEMS, tid_l);
            }
            __syncthreads();
            int cb = convert_one(lds, w_out + (size_t)l * D * D, nullptr, WOUT, D, D, 0, gw_l, ngw, wave_l, lane_l);
            cb = convert_one(lds, w_up + (size_t)l * D * FF, norm_mlp_g + l * D, WUP, D, FF, cb, gw_l, ngw, wave_l, lane_l);
            cb = convert_one(lds, w_down + (size_t)l * FF * D, nullptr, WDN, FF, D, cb, gw_l, ngw, wave_l, lane_l);
            if (l + 1 < DEPTH) cb = convert_one(lds, w_in + (size_t)(l + 1) * D * INW, norm_mix_g + (l + 1) * D, WIN, D, INW, cb, gw_l, ngw, wave_l, lane_l);
            __syncthreads();
            SEAM(pb + 1);
        }
        if (IN(pb + 2)) {
            for (int it = bx; it < NHITEMS; it += G) hgrn_item<true>(lds, U, Yb, SEGS, SEGD, hgrn_norm_g + l * HW, it, tid_l);
            SEAM(pb + 2);
        }
        if (IN(pb + 3)) {
            pg8::Gemm g{Yb, WOUT, M, D, D}; pg8::StaticOrder S; S.init(M, D, G, bx);
            pg8::EpiResid E{X, XB, SS + (size_t)(2 * l + 1) * M * 16};
            pg8::gemm_phase<pg8::EpiResid, pg8::StaticOrder, true, true>(lds, g, S, E);
            SEAM(pb + 3);
        }
        if (IN(pb + 4)) {
            pg8::Gemm g{XB, WUP, M, FF, D}; pg8::StaticOrder S; S.init(M, FF, G, bx);
            pg8::EpiAct E{Hb, FF, SS + (size_t)(2 * l + 1) * M * 16, nullptr, 0};
            pg8::gemm_phase<pg8::EpiAct, pg8::StaticOrder, true, true>(lds, g, S, E);
            SEAM(pb + 4);
        }
        if (IN(pb + 5)) {
            pg8::Gemm g{Hb, WDN, M, D, FF}; pg8::StaticOrder S; S.init(M, D, G, bx);
            pg8::EpiResid E{X, XB, SS + (size_t)(2 * l + 2) * M * 16};
            pg8::gemm_phase<pg8::EpiResid, pg8::StaticOrder, true, true>(lds, g, S, E);
            SEAM(pb + 5);
        }
    }
    if (IN(NPHASES - 1)) {
        const float* ssf = (const float*)(ws + WS_SS) + (size_t)(2 * DEPTH) * M * 16;
        for (int m = gw; m < M; m += ngw) {
            const float rs = rsqrtf(wave_sum(lane < 16 ? ssf[(size_t)m * 16 + lane] : 0.f) * (1.0f / D) + EPS);
            f32x4* xr = (f32x4*)(X + (size_t)m * D) + lane; const f32x4* gr = (const f32x4*)args.in[11] + lane;
#pragma unroll
            for (int j = 0; j < 4; ++j) xr[64 * j] = xr[64 * j] * rs * gr[64 * j];
        }
    }
#undef IN
#undef SEAM
}

__global__ void dbg_digest4(const float* segs, const float* segd, const unsigned short* y, float* out, int n) { int i = blockIdx.x * blockDim.x + threadIdx.x; if (i >= n) return;
    const int ns = 180 * 16384; float v;
    if (i < 192 * 16384) { const int item = i / 16384; v = (item % 16 == 15) ? 0.f : segs[i]; } else if (i < 192 * 16384 + 192 * 128) { const int k = i - 192 * 16384; v = ((k / 128) % 16 == 15) ? 0.f : segd[k]; }
    else if (i < 4 * 1048576) v = 0.f; else { const int k = i - 4 * 1048576; const int r = k / 256, c = k % 256; v = (r < M) ? __uint_as_float((unsigned)y[(size_t)r * 1024 + c] << 16) : 0.f; }
    out[i] = v; }
__global__ void dbg_digest5(const unsigned short* u, float* out, int n) { int i = blockIdx.x * blockDim.x + threadIdx.x; if (i >= n) return; const int r = i / 1024, c = i % 1024;
    const unsigned short* p = u + (size_t)r * 3328 + c; float v = __uint_as_float((unsigned)p[0] << 16) + 2.f * __uint_as_float((unsigned)p[1024] << 16) + 3.f * __uint_as_float((unsigned)p[2048] << 16); if (c < 256) v += 4.f * __uint_as_float((unsigned)p[3072] << 16); out[i] = v; }
__global__ void dbg_digest6(const unsigned short* u, float* out, int n) { int i = blockIdx.x * blockDim.x + threadIdx.x; if (i >= n) return; const int r = i / 1024, c = i % 1024;
    out[i] = (c < 768) ? __uint_as_float((unsigned)u[(size_t)r * 3328 + 1024 + c] << 16) : 0.f; }
__global__ void dbg_digest(const unsigned short* src, float* out, int n) { int i = blockIdx.x * blockDim.x + threadIdx.x; if (i < n) out[i] = __uint_as_float((unsigned)src[i] << 16); }
extern "C" void kernel_launch(void* const* d_in, const int* in_sizes, int n_in, void* d_out, int out_size, void* d_ws, size_t ws_size, hipStream_t stream) {
    static int grid = 0;
    if (grid == 0) {
        if (n_in != 12 || in_sizes[0] != M * D || out_size != M * D || ws_size < WS_END) { fprintf(stderr, "kernel_launch: unexpected shapes (n_in %d, in0 %d, out %d, ws %zu)\n", n_in, n_in > 0 ? in_sizes[0] : -1, out_size, ws_size); grid = -1; return; }
        int dev = 0, cus = 0, per_cu = 0;
        if (hipGetDevice(&dev) != hipSuccess || hipDeviceGetAttribute(&cus, hipDeviceAttributeMultiprocessorCount, dev) != hipSuccess) { grid = -1; return; }
        if (hipFuncSetAttribute((const void*)mk_fwd, hipFuncAttributeMaxDynamicSharedMemorySize, LDS_BYTES) != hipSuccess) { fprintf(stderr, "kernel_launch: hipFuncSetAttribute failed\n"); grid = -1; return; }
        if (hipOccupancyMaxActiveBlocksPerMultiprocessor(&per_cu, (const void*)mk_fwd, NWAVES * 64, LDS_BYTES) != hipSuccess || per_cu < 1) { fprintf(stderr, "kernel_launch: occupancy query says %d\n", per_cu); per_cu = 1; }
        (void)hipGetLastError();
        grid = cus * (per_cu < 1 ? 1 : per_cu);
        if (grid > 256) grid = 256;
    }
    if (grid < 0) return;
    (void)hipMemsetAsync((char*)d_ws + WS_BAR, 0, BAR_ZERO_BYTES, stream);
    Args a{};
    for (int i = 0; i < 12; ++i) a.in[i] = (const float*)d_in[i];
    a.out = (float*)d_out; a.ws = (unsigned char*)d_ws;
#if MK_SINGLE
#ifdef DBG_STOP
    a.ph_lo = 0; a.ph_hi = DBG_STOP;
#else
    a.ph_lo = 0; a.ph_hi = NPHASES;
#endif
    void* kargs[] = {&a};
    hipError_t e = hipLaunchCooperativeKernel((const void*)mk_fwd, dim3(grid), dim3(NWAVES * 64), kargs, LDS_BYTES, stream);
    if (e != hipSuccess) fprintf(stderr, "kernel_launch: cooperative launch failed: %s (grid %d)\n", hipGetErrorString(e), grid);
#if defined(DBG_DIGEST) && DBG_DIGEST == 4
    hipLaunchKernelGGL(dbg_digest4, dim3(M * D / 256), dim3(256), 0, stream, (const float*)((char*)d_ws + WS_SEGS), (const float*)((char*)d_ws + WS_SEGD), (const unsigned short*)((char*)d_ws + WS_Y), (float*)d_out, M * D);
#elif defined(DBG_DIGEST) && DBG_DIGEST == 6
    hipLaunchKernelGGL(dbg_digest6, dim3(M * D / 256), dim3(256), 0, stream, (const unsigned short*)((char*)d_ws + WS_U), (float*)d_out, M * D);
#elif defined(DBG_DIGEST) && DBG_DIGEST == 5
    hipLaunchKernelGGL(dbg_digest5, dim3(M * D / 256), dim3(256), 0, stream, (const unsigned short*)((char*)d_ws + WS_U), (float*)d_out, M * D);
#elif defined(DBG_DIGEST)
    hipLaunchKernelGGL(dbg_digest, dim3(M * D / 256), dim3(256), 0, stream, (const unsigned short*)((char*)d_ws + (DBG_DIGEST == 1 ? WS_Y : (DBG_DIGEST == 2 ? WS_U : WS_XB))), (float*)d_out, M * D);
#endif
#else
#ifndef DBG_STOP
#define DBG_STOP NPHASES
#endif
    for (int p = 0; p < DBG_STOP; ++p) { a.ph_lo = p; a.ph_hi = p + 1; hipLaunchKernelGGL(mk_fwd, dim3(grid), dim3(NWAVES * 64), LDS_BYTES, stream, a); }
#if defined(DBG_DIGEST) && DBG_DIGEST == 4
    hipLaunchKernelGGL(dbg_digest4, dim3(M * D / 256), dim3(256), 0, stream, (const float*)((char*)d_ws + WS_SEGS), (const float*)((char*)d_ws + WS_SEGD), (const unsigned short*)((char*)d_ws + WS_Y), (float*)d_out, M * D);
#elif defined(DBG_DIGEST)
    hipLaunchKernelGGL(dbg_digest, dim3(M * D / 256), dim3(256), 0, stream, (const unsigned short*)((char*)d_ws + (DBG_DIGEST == 1 ? WS_Y : WS_U)), (float*)d_out, M * D);
#endif
#endif
}
```

```cpp
#include <hip/hip_runtime.h>
#include <hip/hip_cooperative_groups.h>
#include <cstdio>
#include <cstdint>
namespace cg = cooperative_groups;
namespace pg8 {
#define PG8_LAS __attribute__((address_space(3)))
typedef unsigned short bf16_t;
typedef short bf16x8 __attribute__((ext_vector_type(8)));
typedef float f32x4 __attribute__((ext_vector_type(4)));
typedef unsigned u32x4 __attribute__((ext_vector_type(4)));
constexpr int BM = 256, BK = 64, HALF = 128, HTB = HALF * BK * 2  , STAGE_BYTES = 8 * HTB, NXCD = 8, WGM = 8;

__host__ __device__ __forceinline__ int lds_byte(int r, int c) { const int st = (r >> 4) * 2 + (c >> 5), rr = r & 15, cc = c & 31, ob = rr * 64 + cc * 2; return st * 1024 + (ob ^ (((ob >> 9) & 1) << 5)); }
__host__ __device__ __forceinline__ void stage_rc(int b, int& R, int& C) { const int st = b / 1024, sb = b % 1024, swz = sb ^ (((sb >> 9) & 1) << 5); R = (st >> 1) * 16 + swz / 64; C = (st & 1) * 32 + (swz % 64) / 2; }
__host__ __device__ __forceinline__ int perm32(int rho) { const int n = rho >> 4, i = rho & 15; return 8 * (i >> 2) + 4 * n + (i & 3); }

struct Unit { int pm, pn; };
struct Gemm { const bf16_t* A; const bf16_t* Bt; int M, N, K; };

struct StaticOrder {
    int nM, nN, nwg, G, c;
    __host__ __device__ void init(int M, int N, int G_, int c_) { nM = M / BM; nN = N / BM; nwg = nM * nN; G = G_; c = c_; }
    __host__ __device__ bool next(int i, Unit& u) const {
        const long L = (long)i * G + c; if (L >= nwg) return false;
        int wgid = (int)L; { const int q = nwg / NXCD, r = nwg % NXCD, xcd = wgid % NXCD, off = wgid / NXCD; wgid = (xcd < r ? xcd * (q + 1) : r * (q + 1) + (xcd - r) * q) + off; }
        const int nig = WGM * nN, gid = wgid / nig, fm = gid * WGM, gsz = (nM - fm) < WGM ? (nM - fm) : WGM;
        u.pm = fm + ((wgid % nig) % gsz); u.pn = (wgid % nig) / gsz; return true;
    }
    __device__ __forceinline__ void a_ready(const Unit&) const {}
    __device__ __forceinline__ void done(const Unit&) const {}
};

__device__ __forceinline__ unsigned cvt_pk_bf16(float lo, float hi) { unsigned r; asm volatile("v_cvt_pk_bf16_f32 %0, %1, %2" : "=v"(r) : "v"(lo), "v"(hi)); return r; }
typedef float f32x2 __attribute__((ext_vector_type(2)));

typedef unsigned u32x2 __attribute__((ext_vector_type(2)));
__device__ __forceinline__ float fast_rcp(float x) { return __builtin_amdgcn_rcpf(x); }
__device__ __forceinline__ float silu_f(float v) { return v * fast_rcp(1.0f + __expf(-v)); }
struct EpiAct {
    static constexpr bool PERM = true, AFTER_DRAIN = false;
    bf16_t* O; int ldc; const float* ss; const float* lb; int is_in;
    __device__ __forceinline__ void operator()(const f32x4 (&acc)[2][2][4][2], const Unit& u, int wr, int wc, int fr, int fq) const {
        const int row0 = u.pm * BM + wr * 64 + fr; const int col0 = u.pn * BM + wc * 32 + 8 * fq;
        int mode = 3;
        if (is_in) { const int t = u.pn; mode = (t == 0) ? 0 : (t <= 3 ? 1 : (t <= 6 ? 2 : (t <= 9 ? 0 : 1))); }
#pragma unroll
        for (int ai = 0; ai < 2; ++ai)
#pragma unroll
            for (int m = 0; m < 4; ++m) { const int r = row0 + ai * HALF + m * 16; const f32x4* sp = (const f32x4*)(ss + (size_t)r * 16); const f32x4 s0 = sp[0], s1 = sp[1], s2 = sp[2], s3 = sp[3];
                const float rs = rsqrtf((((s0[0] + s0[1]) + (s0[2] + s0[3])) + ((s1[0] + s1[1]) + (s1[2] + s1[3])) + (((s2[0] + s2[1]) + (s2[2] + s2[3])) + ((s3[0] + s3[1]) + (s3[2] + s3[3])))) * (1.0f / 1024.0f) + 1e-5f);
                bf16_t* rowp = O + (size_t)r * ldc + col0;
#pragma unroll
                for (int bj = 0; bj < 2; ++bj) { f32x4 v[2]; v[0] = acc[ai][bj][m][0] * rs; v[1] = acc[ai][bj][m][1] * rs;
                    if (mode == 1) {
#pragma unroll
                        for (int n = 0; n < 2; ++n)
#pragma unroll
                            for (int e = 0; e < 4; ++e) v[n][e] = silu_f(v[n][e]);
                    } else if (mode == 2) {
#pragma unroll
                        for (int n = 0; n < 2; ++n)
                            { const f32x4 lv = *(const f32x4*)(lb + (col0 - 1024) + bj * HALF + 4 * n);
#pragma unroll
                            for (int e = 0; e < 4; ++e) { const float s = fast_rcp(1.0f + __expf(-v[n][e])); const float l = lv[e]; v[n][e] = __logf(l + (1.0f - l) * s); } }
                    } else if (mode == 3) {
#pragma unroll
                        for (int n = 0; n < 2; ++n)
#pragma unroll
                            for (int e = 0; e < 4; ++e) { const float t = fmaxf(v[n][e], 0.f); v[n][e] = t * t; }
                    }
                    u32x4 w; w.x = cvt_pk_bf16(v[0][0], v[0][1]); w.y = cvt_pk_bf16(v[0][2], v[0][3]); w.z = cvt_pk_bf16(v[1][0], v[1][1]); w.w = cvt_pk_bf16(v[1][2], v[1][3]);
                    *(u32x4*)(rowp + bj * HALF) = w; }
                asm volatile("" ::: "memory"); }
    }
};
struct EpiResid {
    static constexpr bool PERM = false, AFTER_DRAIN = false;
    float* X; bf16_t* XB; float* ss;
    __device__ __forceinline__ void operator()(const f32x4 (&acc)[2][2][4][2], const Unit& u, int wr, int wc, int fr, int fq) const {
        const int col0 = u.pn * BM + wc * 32 + 4 * fq;
#pragma unroll
        for (int ai = 0; ai < 2; ++ai)
#pragma unroll
            for (int m = 0; m < 4; ++m) { const int r = u.pm * BM + ai * HALF + wr * 64 + m * 16 + fr; const size_t off = (size_t)r * 1024 + col0; float sq = 0.f;
#pragma unroll
                for (int bj = 0; bj < 2; ++bj)
#pragma unroll
                    for (int n = 0; n < 2; ++n) { float* p = X + off + bj * HALF + n * 16; const f32x4 o = *(const f32x4*)p + acc[ai][bj][m][n]; *(f32x4*)p = o;
                        sq += (o[0] * o[0] + o[1] * o[1]) + (o[2] * o[2] + o[3] * o[3]);
                        u32x2 w; w.x = cvt_pk_bf16(o[0], o[1]); w.y = cvt_pk_bf16(o[2], o[3]); *(u32x2*)(XB + off + bj * HALF + n * 16) = w; }
                sq += __shfl_xor(sq, 16); sq += __shfl_xor(sq, 32);
                if (fq == 0) ss[(size_t)r * 16 + u.pn * 4 + wc] = sq;
                asm volatile("" ::: "memory"); }
    }
};

template <class Epi, class Sched, bool ALIGN_EPI = false, bool SP2 = false>
__device__ __forceinline__ void gemm_phase(PG8_LAS unsigned char* lds, const Gemm g, const Sched& S, const Epi& E) {
    int tid_ = threadIdx.x; asm volatile("" : "+v"(tid_));
    const int tid = tid_, wid = __builtin_amdgcn_readfirstlane(tid >> 6), lane = tid & 63, wr = wid >> 2, wc = wid & 3, fr = lane & 15, fq = lane >> 4;
    const int K = g.K, nt = K / BK;
    unsigned voffA[2], voffB[2];
#pragma unroll
    for (int i = 0; i < 2; ++i) { int R, C; stage_rc(tid * 16 + i * 8192, R, C); const int Rb = Epi::PERM ? ((R & ~31) + perm32(R & 31)) : R;
        voffA[i] = (unsigned)(R * K + C) * 2u; voffB[i] = (unsigned)(Rb * K + C) * 2u; }
    const size_t kstep = (size_t)(BK * 2);
    const size_t hstep = (size_t)HALF * K * 2;
    const size_t tstep = 2 * hstep;
    const unsigned ldsw = (unsigned)wid * 1024u;
    const int aoff = lds_byte(wr * 64 + fr, fq * 8), boff = lds_byte(wc * 32 + fr, fq * 8);
#define PG8_SA(b, h) (((b) * 2 + (h)) * HTB)
#define PG8_SB(b, h) ((4 + (b) * 2 + (h)) * HTB)
#define PG8_STAGE(bufoff, gbase, voff) do { _Pragma("unroll") for (int _i = 0; _i < 2; ++_i) \
        __builtin_amdgcn_global_load_lds((const unsigned*)((const char*)(gbase) + (voff)[_i]), (PG8_LAS unsigned*)(lds + (bufoff) + ldsw + _i * 8192), 16, 0, 0); } while (0)
#define PG8_LDA(dst, b, h) do { _Pragma("unroll") for (int m = 0; m < 4; ++m) _Pragma("unroll") for (int k = 0; k < 2; ++k) dst[m][k] = *(const PG8_LAS bf16x8*)(lds + PG8_SA(b, h) + aoff + m * 2048 + k * 1024); } while (0)
#define PG8_LDB(dst, b, h) do { _Pragma("unroll") for (int n = 0; n < 2; ++n) _Pragma("unroll") for (int k = 0; k < 2; ++k) dst[n][k] = *(const PG8_LAS bf16x8*)(lds + PG8_SB(b, h) + boff + n * 2048 + k * 1024); } while (0)
#define PG8_MMA(ai, bj, At, Bt) do { __builtin_amdgcn_s_setprio(1); _Pragma("unroll") for (int m = 0; m < 4; ++m) _Pragma("unroll") for (int n = 0; n < 2; ++n) _Pragma("unroll") for (int k = 0; k < 2; ++k) \
        acc[ai][bj][m][n] = __builtin_amdgcn_mfma_f32_16x16x32_bf16(Bt[n][k], At[m][k], acc[ai][bj][m][n], 0, 0, 0); __builtin_amdgcn_s_setprio(0); } while (0)
#define PG8_WAIT_V(n) asm volatile("s_waitcnt vmcnt(" #n ")" ::: "memory")
#define PG8_WAIT_L(n) asm volatile("s_waitcnt lgkmcnt(" #n ")" ::: "memory")
#define PG8_BAR __builtin_amdgcn_s_barrier()
#define PG8_SCHED __builtin_amdgcn_sched_barrier(0)
    Unit cur, nxt; int ui = 0;
    if (!S.next(0, cur)) return;
    f32x4 acc[2][2][4][2];
#pragma unroll
    for (int a = 0; a < 2; ++a)
#pragma unroll
        for (int b = 0; b < 2; ++b)
#pragma unroll
            for (int m = 0; m < 4; ++m)
#pragma unroll
                for (int n = 0; n < 2; ++n) acc[a][b][m][n] = (f32x4){0.f, 0.f, 0.f, 0.f};
    bf16x8 At[4][2], B0[2][2], B1[2][2];
    const char* cA = (const char*)g.A + (size_t)cur.pm * tstep; const char* cB = (const char*)g.Bt + (size_t)cur.pn * tstep;
    S.a_ready(cur);
    if constexpr (SP2) {
        PG8_STAGE(PG8_SB(0, 0), cB, voffB); PG8_STAGE(PG8_SB(0, 1), cB + hstep, voffB); PG8_STAGE(PG8_SA(0, 0), cA, voffA); PG8_STAGE(PG8_SA(0, 1), cA + hstep, voffA);
        if (wr == 1) PG8_BAR;
        PG8_WAIT_V(2); PG8_BAR;
        PG8_STAGE(PG8_SB(1, 0), cB + kstep, voffB); PG8_STAGE(PG8_SA(1, 0), cA + kstep, voffA); PG8_STAGE(PG8_SB(1, 1), cB + hstep + kstep, voffB);
        PG8_WAIT_V(6); PG8_BAR;
    } else {
        PG8_STAGE(PG8_SB(0, 0), cB, voffB); PG8_STAGE(PG8_SA(0, 0), cA, voffA); PG8_STAGE(PG8_SB(0, 1), cB + hstep, voffB); PG8_STAGE(PG8_SA(0, 1), cA + hstep, voffA);
        if (wr == 1) PG8_BAR;
        PG8_WAIT_V(4); PG8_BAR;
        PG8_STAGE(PG8_SB(1, 0), cB + kstep, voffB); PG8_STAGE(PG8_SA(1, 0), cA + kstep, voffA); PG8_STAGE(PG8_SB(1, 1), cB + hstep + kstep, voffB);
        PG8_WAIT_V(6); PG8_BAR;
    }
    for (;;) {
        const bool has_next = S.next(ui + 1, nxt);
        const char* nA = has_next ? (const char*)g.A + (size_t)nxt.pm * tstep : cA; const char* nB = has_next ? (const char*)g.Bt + (size_t)nxt.pn * tstep : cB;
        for (int t = 0; t < nt; t += 2) {
            const bool last = (t == nt - 2);
            const char* a1 = cA + (size_t)(t + 1) * kstep;
            const char* a2 = last ? nA : cA + (size_t)(t + 2) * kstep; const char* b2 = last ? nB : cB + (size_t)(t + 2) * kstep;
            const char* a3 = a2 + kstep; const char* b3 = b2 + kstep;
            if (last && has_next) S.a_ready(nxt);
            if constexpr (SP2) {
            PG8_LDB(B0, 0, 0); PG8_LDB(B1, 0, 1); PG8_SCHED; PG8_LDA(At, 0, 0); PG8_STAGE(PG8_SA(1, 1), a1 + hstep, voffA);
            PG8_WAIT_V(8); PG8_WAIT_L(0); PG8_BAR; PG8_MMA(0, 0, At, B0); PG8_MMA(0, 1, At, B1); PG8_BAR; PG8_SCHED;
            PG8_LDA(At, 0, 1); PG8_STAGE(PG8_SB(0, 0), b2, voffB); PG8_STAGE(PG8_SB(0, 1), b2 + hstep, voffB); PG8_STAGE(PG8_SA(0, 0), a2, voffA);
            PG8_WAIT_V(8); PG8_WAIT_L(0); PG8_BAR; PG8_MMA(1, 0, At, B0); PG8_MMA(1, 1, At, B1); PG8_BAR; PG8_SCHED;
            PG8_LDB(B0, 1, 0); PG8_LDB(B1, 1, 1); PG8_SCHED; PG8_LDA(At, 1, 0); PG8_STAGE(PG8_SA(0, 1), a2 + hstep, voffA);
            PG8_WAIT_V(8); PG8_WAIT_L(0); PG8_BAR; PG8_MMA(0, 0, At, B0); PG8_MMA(0, 1, At, B1); PG8_BAR; PG8_SCHED;
            PG8_LDA(At, 1, 1); PG8_STAGE(PG8_SB(1, 0), b3, voffB); PG8_STAGE(PG8_SB(1, 1), b3 + hstep, voffB); PG8_STAGE(PG8_SA(1, 0), a3, voffA);
            PG8_WAIT_V(8); PG8_WAIT_L(0); PG8_BAR; PG8_MMA(1, 0, At, B0); PG8_MMA(1, 1, At, B1); PG8_BAR; PG8_SCHED;
            } else {
            PG8_LDB(B0, 0, 0); PG8_SCHED; PG8_LDA(At, 0, 0); PG8_STAGE(PG8_SA(1, 1), a1 + hstep, voffA);
            PG8_WAIT_L(8); PG8_BAR; PG8_WAIT_L(0); PG8_MMA(0, 0, At, B0); PG8_BAR; PG8_SCHED;
            PG8_LDB(B1, 0, 1); PG8_STAGE(PG8_SB(0, 0), b2, voffB);
            PG8_BAR; PG8_WAIT_L(0); PG8_MMA(0, 1, At, B1); PG8_BAR;
            PG8_LDA(At, 0, 1); PG8_STAGE(PG8_SA(0, 0), a2, voffA);
            PG8_BAR; PG8_WAIT_L(0); PG8_MMA(1, 0, At, B0); PG8_BAR; PG8_SCHED;
            PG8_STAGE(PG8_SB(0, 1), b2 + hstep, voffB);
            PG8_WAIT_V(6); PG8_BAR; PG8_MMA(1, 1, At, B1); PG8_BAR;
            PG8_LDB(B0, 1, 0); PG8_SCHED; PG8_LDA(At, 1, 0); PG8_STAGE(PG8_SA(0, 1), a2 + hstep, voffA);
            PG8_WAIT_L(8); PG8_BAR; PG8_WAIT_L(0); PG8_MMA(0, 0, At, B0); PG8_BAR; PG8_SCHED;
            PG8_LDB(B1, 1, 1); PG8_STAGE(PG8_SB(1, 0), b3, voffB);
            PG8_BAR; PG8_WAIT_L(0); PG8_MMA(0, 1, At, B1); PG8_BAR;
            PG8_LDA(At, 1, 1); PG8_STAGE(PG8_SA(1, 0), a3, voffA);
            PG8_BAR; PG8_WAIT_L(0); PG8_MMA(1, 0, At, B0); PG8_BAR; PG8_SCHED;
            PG8_STAGE(PG8_SB(1, 1), b3 + hstep, voffB);
            PG8_WAIT_V(6); PG8_BAR; PG8_MMA(1, 1, At, B1); PG8_BAR;
            }
        }
        if constexpr (ALIGN_EPI) { if (wr == 0) PG8_BAR; }
        if constexpr (!Epi::AFTER_DRAIN) { E(acc, cur, wr, wc, fr, fq); S.done(cur); }
        if (!has_next) break;
#pragma unroll
        for (int a = 0; a < 2; ++a)
#pragma unroll
            for (int b = 0; b < 2; ++b)
#pragma unroll
                for (int m = 0; m < 4; ++m)
#pragma unroll
                    for (int n = 0; n < 2; ++n) acc[a][b][m][n] = (f32x4){0.f, 0.f, 0.f, 0.f};
        cur = nxt; cA = nA; cB = nB; ++ui;
        if constexpr (ALIGN_EPI) { if (wr == 1) PG8_BAR; }
    }
    PG8_WAIT_V(0);
    if constexpr (!ALIGN_EPI) { if (wr == 0) PG8_BAR; }
    PG8_BAR;
    if constexpr (Epi::AFTER_DRAIN) { E.fused(acc, cur, wr, wc, fr, fq, lds, wid, lane); S.done(cur); }
#undef PG8_SA
#undef PG8_SB
#undef PG8_STAGE
#undef PG8_LDA
#undef PG8_LDB
#undef PG8_MMA
#undef PG8_WAIT_V
#undef PG8_WAIT_L
#undef PG8_BAR
#undef PG8_SCHED
}
}

#ifndef MK_SINGLE
#define MK_SINGLE 1
#endif
constexpr int NWAVES = 8;
constexpr int M = 16384, D = 1024, INW = 3328, FF = 4096, SEQ = 8192, NH = 6, HD = 128, PW = 256, DEPTH = 4, HW = 768;
constexpr int SEGL = 512, NSEG = SEQ / SEGL, NCH = SEGL / 64, NHITEMS = 2 * NH * NSEG;
constexpr int NPOOL = M / 256;
constexpr float EPS = 1e-5f;
constexpr int NPHASES = 2 + 6 * DEPTH;
constexpr size_t MiB = 1u << 20;
constexpr size_t WS_BAR = 0, BAR_ZERO_BYTES = 16384;
constexpr size_t WS_LB = 1 * MiB;
constexpr size_t WS_WIN = 2 * MiB, WS_WOUT = 9 * MiB, WS_WUP = 11 * MiB, WS_WDN = 19 * MiB;
constexpr size_t WS_XB = 27 * MiB, WS_Y = 59 * MiB;
constexpr size_t WS_SEGS = 91 * MiB, WS_SEGD = 103 * MiB;
constexpr size_t WS_U = 104 * MiB;
constexpr size_t WS_SS = 232 * MiB;
constexpr size_t WS_END = 241 * MiB;
static_assert(WS_SS + 9 * (size_t)M * 64 <= WS_END && WS_WIN + (size_t)INW * D * 2 <= WS_WOUT && WS_SEGS + (size_t)NHITEMS * 65536 <= WS_SEGD && WS_U + (size_t)M * FF * 2 <= WS_SS, "ws map");
constexpr int LDS_BYTES = 147456;
constexpr int MISC_OFF = 131072;
constexpr int QP = 136, SP = 72, OP = 132;
constexpr int Q_OFF = 0, KT_OFF = 17408, OB_OFF = 0  , KH_OFF = 34816, VT_OFF = 53248, ST_OFF = 71680, PM_OFF = 106496, TOT_OFF = 115712, DV_OFF = 119808, DS_OFF = 120320;
static_assert(64 * OP * 4 <= KH_OFF && DS_OFF + 512 <= 131072, "mixer LDS map");
constexpr int PPP = 264;
constexpr int PP_OFF = 0, WT_OFF = 128 * PPP * 2;
static_assert(WT_OFF + 256 * SP * 2 <= 131072, "pool LDS map");

#define LAS __attribute__((address_space(3)))
#define GAS __attribute__((address_space(1)))
typedef unsigned short bf16;
typedef float f32x4 __attribute__((ext_vector_type(4)));
typedef float f32x2 __attribute__((ext_vector_type(2)));
typedef short bf16x8 __attribute__((ext_vector_type(8)));
typedef unsigned u32x4 __attribute__((ext_vector_type(4)));
typedef unsigned u32x2 __attribute__((ext_vector_type(2)));
typedef __bf16 bf16x2_t __attribute__((ext_vector_type(2)));
__device__ __forceinline__ unsigned pk2(float lo, float hi) { f32x2 v = {lo, hi}; bf16x2_t b = __builtin_convertvector(v, bf16x2_t); return __builtin_bit_cast(unsigned, b); }
__device__ __forceinline__ float bflo(unsigned u) { return __uint_as_float(u << 16); }
__device__ __forceinline__ float bfhi(unsigned u) { return __uint_as_float(u & 0xffff0000u); }
__device__ __forceinline__ float wave_sum(float v) {
#pragma unroll
    for (int o = 1; o < 64; o <<= 1) v += __shfl_xor(v, o);
    return v;
}
#define MFMA16(a, b, c) __builtin_amdgcn_mfma_f32_16x16x32_bf16((a), (b), (c), 0, 0, 0)

__device__ __forceinline__ void transpose_item(const float* W, const float* g, int K, int N, bf16* WT, LAS float* scr, int item, int lane) {
    const int nblk = N / 32, kb = item / nblk, nb = item % nblk, k0 = 64 * kb, n0 = 32 * nb;
    const int kr = lane >> 3, nq = lane & 7;
    const GAS float* Wg = (const GAS float*)W + (size_t)(k0 + kr) * N + n0 + 4 * nq;
    f32x4 v[8];
#pragma unroll
    for (int i = 0; i < 8; ++i) v[i] = *(const GAS f32x4*)(Wg + (size_t)(8 * i) * N);
    if (g) {
#pragma unroll
        for (int i = 0; i < 8; ++i) v[i] = v[i] * g[k0 + 8 * i + kr];
    }
#pragma unroll
    for (int i = 0; i < 8; ++i) { LAS float* d = scr + (8 * i + kr) * 33 + 4 * nq; d[0] = v[i][0]; d[1] = v[i][1]; d[2] = v[i][2]; d[3] = v[i][3]; }
    asm volatile("s_waitcnt lgkmcnt(0)" ::: "memory");
    const int c = lane & 7;
#pragma unroll
    for (int j = 0; j < 4; ++j) { const int n = (lane >> 3) + 8 * j; const LAS float* s = scr + (8 * c) * 33 + n;
        u32x4 o; o.x = pk2(s[0 * 33], s[1 * 33]); o.y = pk2(s[2 * 33], s[3 * 33]); o.z = pk2(s[4 * 33], s[5 * 33]); o.w = pk2(s[6 * 33], s[7 * 33]);
        *(GAS u32x4*)(WT + (size_t)(n0 + n) * K + k0 + 8 * c) = o; }
    asm volatile("s_waitcnt lgkmcnt(0)" ::: "memory");
}
__device__ __forceinline__ int convert_one(LAS unsigned char* lds, const float* W, const float* g, bf16* WT, int K, int N, int base, int gw, int ngw, int wave, int lane) {
    LAS float* scr = (LAS float*)(lds + wave * 16384);
    const int nit = (K / 64) * (N / 32);
    int it = (gw - base % ngw + ngw) % ngw;
    for (; it < nit; it += ngw) transpose_item(W, g, K, N, WT, scr, it, lane);
    return base + nit;
}

#define XB_TMO      128
#define XB_XCNT(j)  (256  + 64 * (j))
#define XB_XSUB(j)  (1280 + 64 * (j))
#define XB_XGEN(j)  (2304 + 64 * (j))
#define XB_TOP      3328
#define XB_TOPGEN   3392
#define XCD_BAR_WORDS 3456
#define XB_SPIN_CAP (1u << 18)

__device__ __forceinline__ unsigned xb_ld(unsigned* p)              { return __hip_atomic_load(p, __ATOMIC_RELAXED, __HIP_MEMORY_SCOPE_AGENT); }
__device__ __forceinline__ unsigned xb_add(unsigned* p, unsigned v) { return __hip_atomic_fetch_add(p, v, __ATOMIC_RELAXED, __HIP_MEMORY_SCOPE_AGENT); }
__device__ __forceinline__ unsigned xb_xcc_id() { return (unsigned)__builtin_amdgcn_s_getreg((3 << 11) | 20) & 0xFu; }
#define XB_SPIN(cond, bar) do { unsigned _sp = 0; while (cond) { __builtin_amdgcn_s_sleep(1); \
    if ((++_sp & 255u) == 0u) { if (xb_ld(&(bar)[XB_TMO])) break; if (_sp > XB_SPIN_CAP) { atomicAdd(&(bar)[XB_TMO], 1u); break; } } } } while (0)

struct XcdBarrier {
    unsigned* bar; unsigned x;
    volatile LAS unsigned* st;
};

__device__ __forceinline__ XcdBarrier xcd_barrier_post(unsigned* bar, volatile LAS unsigned* st) {
    XcdBarrier b; b.bar = bar; b.x = xb_xcc_id(); b.st = st;
    if (threadIdx.x == 0) (void)xb_add(&bar[XB_XCNT(b.x)], 1u);
    return b;
}
__device__ __forceinline__ void xcd_barrier_complete(unsigned* bar, unsigned x, unsigned& nloc, unsigned& nx) {
    const unsigned G = gridDim.x * gridDim.y * gridDim.z;
    unsigned sum, cnt, mine, sp = 0u;
    for (;;) {
        sum = 0u; cnt = 0u; mine = 0u;
#pragma unroll
        for (unsigned j = 0; j < 16; ++j) { const unsigned c = xb_ld(&bar[XB_XCNT(j)]); sum += c; cnt += (c > 0u) ? 1u : 0u; mine = (j == x) ? c : mine; }
        if (sum == G) break;
        __builtin_amdgcn_s_sleep(1);
        if ((++sp & 255u) == 0u) { if (xb_ld(&bar[XB_TMO])) break; if (sp > XB_SPIN_CAP) { atomicAdd(&bar[XB_TMO], 1u); break; } }
    }
    nloc = mine > 0u ? mine : 1u; nx = cnt > 0u ? cnt : 1u;
}

__device__ __forceinline__ void xcd_barrier(const XcdBarrier& b) {
    asm volatile("s_waitcnt vmcnt(0)" ::: "memory");
    __syncthreads();
    if (threadIdx.x == 0) {
        unsigned* bar = b.bar;
        __builtin_amdgcn_s_waitcnt(0);
        unsigned nloc = b.st[0], nx = b.st[1];
        if (nloc == 0u) { xcd_barrier_complete(bar, b.x, nloc, nx); b.st[0] = nloc; b.st[1] = nx; }
        const unsigned old = xb_add(&bar[XB_XSUB(b.x)], 1u);
        const unsigned gen = old / nloc;
        if (old + 1u == (gen + 1u) * nloc) {
            __builtin_amdgcn_fence(__ATOMIC_RELEASE, "agent");
            asm volatile("s_waitcnt vmcnt(0)" ::: "memory");
            const unsigned og = xb_add(&bar[XB_TOP], 1u);
            const unsigned tg = og / nx;
            if (og + 1u == (tg + 1u) * nx) xb_add(&bar[XB_TOPGEN], 1u);
            else XB_SPIN(xb_ld(&bar[XB_TOPGEN]) == tg, bar);
            __builtin_amdgcn_fence(__ATOMIC_ACQUIRE, "agent");
            xb_add(&bar[XB_XGEN(b.x)], 1u);
            asm volatile("s_waitcnt vmcnt(0)" ::: "memory");
        } else {
            XB_SPIN(xb_ld(&bar[XB_XGEN(b.x)]) == gen, bar);
            __builtin_amdgcn_fence(__ATOMIC_ACQUIRE, "agent");
            asm volatile("s_waitcnt vmcnt(0)" ::: "memory");
        }
    }
    __syncthreads();
}

template <bool FULL>
__device__ __forceinline__ void hgrn_item(LAS unsigned char* lds, const bf16* U, bf16* Y, float* SEGS, float* SEGD, const float* normg, int item, int tid) {
    const int lane = tid & 63, w = __builtin_amdgcn_readfirstlane(tid >> 6), fr = lane & 15, fq = lane >> 4;
    const int j = item % NSEG, bh = item / NSEG, h = bh % NH, b = bh / NH;
    if (!FULL && j == NSEG - 1) return;
    const int row0 = b * SEQ + j * SEGL;
    LAS bf16* Qs = (LAS bf16*)(lds + Q_OFF); LAS bf16* KT = (LAS bf16*)(lds + KT_OFF); LAS bf16* KH = (LAS bf16*)(lds + KH_OFF); LAS bf16* VT = (LAS bf16*)(lds + VT_OFF);
    LAS bf16* ST = (LAS bf16*)(lds + ST_OFF); LAS bf16* PM = (LAS bf16*)(lds + PM_OFF); LAS float* OB = (LAS float*)(lds + OB_OFF);
    LAS float* TOT = (LAS float*)(lds + TOT_OFF); LAS float* DV = (LAS float*)(lds + DV_OFF); LAS float* DS = (LAS float*)(lds + DS_OFF);
    f32x4 S[8];
#pragma unroll
    for (int vt = 0; vt < 8; ++vt) S[vt] = (f32x4){0.f, 0.f, 0.f, 0.f};
    if (tid < 128) DS[tid] = 0.f;
    if (FULL) {
        f32x4 P = (f32x4){1.f, 1.f, 1.f, 1.f};
        for (int i = j - 1; i >= 0; --i) {
            const GAS float* Ki = (const GAS float*)SEGS + (size_t)(bh * NSEG + i) * 16384; const f32x4 dv = *(const GAS f32x4*)((const GAS float*)SEGD + (size_t)(bh * NSEG + i) * 128 + 16 * w + 4 * fq);
            f32x4 kv[8];
#pragma unroll
            for (int vt = 0; vt < 8; ++vt) kv[vt] = *(const GAS f32x4*)(Ki + (size_t)((vt * 8 + w) * 64 + lane) * 4);
#pragma unroll
            for (int vt = 0; vt < 8; ++vt) S[vt] = S[vt] + P * kv[vt];
            P = P * dv;
            if (__ballot((P[0] != 0.f) | (P[1] != 0.f) | (P[2] != 0.f) | (P[3] != 0.f)) == 0ull) break;
        }
#pragma unroll
        for (int vt = 0; vt < 8; ++vt) { u32x2 o; o.x = pk2(S[vt][0], S[vt][1]); o.y = pk2(S[vt][2], S[vt][3]); *(LAS u32x2*)(ST + (16 * vt + fr) * QP + 16 * w + 4 * fq) = o; }
    }
    __syncthreads();
    unsigned lf2[8], v2[8], q2[8];
#define HG_LOAD(cc) do { const GAS bf16* up_ = (const GAS bf16*)U + (size_t)(row0 + (cc) * 64 + 8 * w) * INW + h * HD + 2 * lane; _Pragma("unroll") for (int jj = 0; jj < 8; ++jj) { \
        lf2[jj] = *(const GAS unsigned*)(up_ + (size_t)jj * INW + 1024); v2[jj] = *(const GAS unsigned*)(up_ + (size_t)jj * INW + 1792); q2[jj] = FULL ? *(const GAS unsigned*)(up_ + (size_t)jj * INW + 256) : 0u; } } while (0)
    HG_LOAD(0);
    for (int c = 0; c < NCH; ++c) {
        const int r0 = row0 + c * 64;
        float bl0[8], bl1[8]; float a0 = 0.f, a1 = 0.f;
#pragma unroll
        for (int jj = 0; jj < 8; ++jj) { a0 += bflo(lf2[jj]); a1 += bfhi(lf2[jj]); bl0[jj] = a0; bl1[jj] = a1; }
        *(LAS f32x2*)(TOT + w * 128 + 2 * lane) = (f32x2){a0, a1};
        __syncthreads();
        float p0 = 0.f, p1 = 0.f, t0 = 0.f, t1 = 0.f;
#pragma unroll
        for (int g = 0; g < 8; ++g) { const f32x2 tv = *(const LAS f32x2*)(TOT + g * 128 + 2 * lane); if (g < w) { p0 += tv.x; p1 += tv.y; } t0 += tv.x; t1 += tv.y; }
        if (w == 0) { *(LAS f32x2*)(DV + 2 * lane) = (f32x2){__expf(t0), __expf(t1)}; const f32x2 ds = *(const LAS f32x2*)(DS + 2 * lane); *(LAS f32x2*)(DS + 2 * lane) = (f32x2){ds.x + t0, ds.y + t1}; }
        float kh0[8], kh1[8];
#pragma unroll
        for (int jj = 0; jj < 8; ++jj) {
            const float b0 = p0 + bl0[jj], b1 = p1 + bl1[jj];
            const float k0 = 1.0f - __expf(bflo(lf2[jj])), k1 = 1.0f - __expf(bfhi(lf2[jj]));
            kh0[jj] = k0 * __expf(t0 - b0); kh1[jj] = k1 * __expf(t1 - b1);
            if (FULL) {
                const float bc0 = fmaxf(b0, -80.f), bc1 = fmaxf(b1, -80.f);
                const float e0 = __expf(bc0), e1 = __expf(bc1), i0 = __expf(-bc0), i1 = __expf(-bc1);
                *(LAS unsigned*)(Qs + (8 * w + jj) * QP + 2 * lane) = pk2(bflo(q2[jj]) * e0, bfhi(q2[jj]) * e1);
                *(LAS unsigned*)(KT + (8 * w + jj) * QP + 2 * lane) = pk2(k0 * i0, k1 * i1);
            }
        }
        { u32x4 o; o.x = pk2(kh0[0], kh0[1]); o.y = pk2(kh0[2], kh0[3]); o.z = pk2(kh0[4], kh0[5]); o.w = pk2(kh0[6], kh0[7]); *(LAS u32x4*)(KH + (2 * lane) * SP + 8 * w) = o;
          o.x = pk2(kh1[0], kh1[1]); o.y = pk2(kh1[2], kh1[3]); o.z = pk2(kh1[4], kh1[5]); o.w = pk2(kh1[6], kh1[7]); *(LAS u32x4*)(KH + (2 * lane + 1) * SP + 8 * w) = o;
          o.x = (v2[0] & 0xffffu) | (v2[1] << 16); o.y = (v2[2] & 0xffffu) | (v2[3] << 16); o.z = (v2[4] & 0xffffu) | (v2[5] << 16); o.w = (v2[6] & 0xffffu) | (v2[7] << 16); *(LAS u32x4*)(VT + (2 * lane) * SP + 8 * w) = o;
          o.x = (v2[0] >> 16) | (v2[1] & 0xffff0000u); o.y = (v2[2] >> 16) | (v2[3] & 0xffff0000u); o.z = (v2[4] >> 16) | (v2[5] & 0xffff0000u); o.w = (v2[6] >> 16) | (v2[7] & 0xffff0000u); *(LAS u32x4*)(VT + (2 * lane + 1) * SP + 8 * w) = o; }
        const int t_e = tid >> 3, vs_e = (tid & 7) * 16;
        u32x4 g0 = (u32x4){0u, 0u, 0u, 0u}, g1 = g0;
        if constexpr (FULL) { const GAS bf16* gp = (const GAS bf16*)U + (size_t)(r0 + t_e) * INW + 2560 + h * HD + vs_e; g0 = *(const GAS u32x4*)gp; g1 = *(const GAS u32x4*)(gp + 8); }
        if (c + 1 < NCH) HG_LOAD(c + 1);
        __syncthreads();
        const int tt = w >> 1;
        f32x4 oa[4];
        if constexpr (FULL) {
#pragma unroll
            for (int ti = 0; ti < 2; ++ti) { const int ts = (w & 1) * 2 + ti; f32x4 pa = (f32x4){0.f, 0.f, 0.f, 0.f};
                if (ts <= tt) {
#pragma unroll
                    for (int kk = 0; kk < 4; ++kk) { const bf16x8 a = *(const LAS bf16x8*)(KT + (ts * 16 + fr) * QP + kk * 32 + 8 * fq); const bf16x8 bq = *(const LAS bf16x8*)(Qs + (tt * 16 + fr) * QP + kk * 32 + 8 * fq); pa = MFMA16(a, bq, pa); }
                    if (ts == tt) {
#pragma unroll
                        for (int i = 0; i < 4; ++i) if (4 * fq + i > fr) pa[i] = 0.f;
                    }
                }
                u32x2 o; o.x = pk2(pa[0], pa[1]); o.y = pk2(pa[2], pa[3]); *(LAS u32x2*)(PM + (tt * 16 + fr) * SP + ts * 16 + 4 * fq) = o; }
            bf16x8 qf[4];
#pragma unroll
            for (int kk = 0; kk < 4; ++kk) qf[kk] = *(const LAS bf16x8*)(Qs + (tt * 16 + fr) * QP + kk * 32 + 8 * fq);
#pragma unroll
            for (int vi = 0; vi < 4; ++vi) { const int vt = (w & 1) * 4 + vi; oa[vi] = (f32x4){0.f, 0.f, 0.f, 0.f};
#pragma unroll
                for (int kk = 0; kk < 4; ++kk) { const bf16x8 sf = *(const LAS bf16x8*)(ST + (vt * 16 + fr) * QP + kk * 32 + 8 * fq); oa[vi] = MFMA16(sf, qf[kk], oa[vi]); } }
            __syncthreads();
            bf16x8 pf[2];
#pragma unroll
            for (int kk = 0; kk < 2; ++kk) pf[kk] = *(const LAS bf16x8*)(PM + (tt * 16 + fr) * SP + kk * 32 + 8 * fq);
#pragma unroll
            for (int vi = 0; vi < 4; ++vi) { const int vt = (w & 1) * 4 + vi;
#pragma unroll
                for (int kk = 0; kk < 2; ++kk) { const bf16x8 vf = *(const LAS bf16x8*)(VT + (vt * 16 + fr) * SP + kk * 32 + 8 * fq); oa[vi] = MFMA16(vf, pf[kk], oa[vi]); } }
        }
        { const f32x4 dv = *(const LAS f32x4*)(DV + 16 * w + 4 * fq); bf16x8 kf[2];
#pragma unroll
          for (int kk = 0; kk < 2; ++kk) kf[kk] = *(const LAS bf16x8*)(KH + (16 * w + fr) * SP + kk * 32 + 8 * fq);
#pragma unroll
          for (int vt = 0; vt < 8; ++vt) { S[vt] = S[vt] * dv;
#pragma unroll
              for (int kk = 0; kk < 2; ++kk) { const bf16x8 vf = *(const LAS bf16x8*)(VT + (vt * 16 + fr) * SP + kk * 32 + 8 * fq); S[vt] = MFMA16(kf[kk], vf, S[vt]); } } }
        if constexpr (FULL) {
            __syncthreads();
#pragma unroll
            for (int vt = 0; vt < 8; ++vt) { u32x2 o; o.x = pk2(S[vt][0], S[vt][1]); o.y = pk2(S[vt][2], S[vt][3]); *(LAS u32x2*)(ST + (16 * vt + fr) * QP + 16 * w + 4 * fq) = o; }
#pragma unroll
            for (int vi = 0; vi < 4; ++vi) { const int vt = (w & 1) * 4 + vi; *(LAS f32x4*)(OB + (tt * 16 + fr) * OP + vt * 16 + 4 * fq) = oa[vi]; }
            __syncthreads();
            const int t = t_e, vs = vs_e;
            f32x4 o4[4]; float ssq = 0.f;
#pragma unroll
            for (int q = 0; q < 4; ++q) { o4[q] = *(const LAS f32x4*)(OB + t * OP + vs + 4 * q); ssq += (o4[q][0] * o4[q][0] + o4[q][1] * o4[q][1]) + (o4[q][2] * o4[q][2] + o4[q][3] * o4[q][3]); }
            ssq += __shfl_xor(ssq, 1); ssq += __shfl_xor(ssq, 2); ssq += __shfl_xor(ssq, 4);
            const float rs = rsqrtf(ssq * (1.0f / 128.0f) + EPS);
            const GAS float* ng = (const GAS float*)normg + h * HD + vs;
            const f32x4 n0 = *(const GAS f32x4*)ng, n1 = *(const GAS f32x4*)(ng + 4), n2 = *(const GAS f32x4*)(ng + 8), n3 = *(const GAS f32x4*)(ng + 12);
            u32x4 y0, y1;
            y0.x = pk2(o4[0][0] * rs * n0[0] * bflo(g0.x), o4[0][1] * rs * n0[1] * bfhi(g0.x)); y0.y = pk2(o4[0][2] * rs * n0[2] * bflo(g0.y), o4[0][3] * rs * n0[3] * bfhi(g0.y));
            y0.z = pk2(o4[1][0] * rs * n1[0] * bflo(g0.z), o4[1][1] * rs * n1[1] * bfhi(g0.z)); y0.w = pk2(o4[1][2] * rs * n1[2] * bflo(g0.w), o4[1][3] * rs * n1[3] * bfhi(g0.w));
            y1.x = pk2(o4[2][0] * rs * n2[0] * bflo(g1.x), o4[2][1] * rs * n2[1] * bfhi(g1.x)); y1.y = pk2(o4[2][2] * rs * n2[2] * bflo(g1.y), o4[2][3] * rs * n2[3] * bfhi(g1.y));
            y1.z = pk2(o4[3][0] * rs * n3[0] * bflo(g1.z), o4[3][1] * rs * n3[1] * bfhi(g1.z)); y1.w = pk2(o4[3][2] * rs * n3[2] * bflo(g1.w), o4[3][3] * rs * n3[3] * bfhi(g1.w));
            GAS bf16* yp = (GAS bf16*)Y + (size_t)(r0 + t) * D + PW + h * HD + vs;
            *(GAS u32x4*)yp = y0; *(GAS u32x4*)(yp + 8) = y1;
        }
    }
    if (!FULL) {
#pragma unroll
        for (int vt = 0; vt < 8; ++vt) *(GAS f32x4*)((GAS float*)SEGS + (size_t)item * 16384 + (size_t)((vt * 8 + w) * 64 + lane) * 4) = S[vt];
        if (tid < 128) SEGD[(size_t)item * 128 + tid] = __expf(DS[tid]);
    }
    __syncthreads();
#undef HG_LOAD
}

template <int WIN>
__device__ __forceinline__ void pool_run(LAS bf16* PP, const bf16* U, int R, int tl0, int g, int pair) {
    const bf16* up = U + (size_t)R * INW + g * 64 + 2 * pair; const int tseq0 = R % SEQ;
    unsigned xv[16 + WIN - 1];
#pragma unroll
    for (int i = 0; i < 16 + WIN - 1; ++i) { const int tt = i - (WIN - 1); xv[i] = (tseq0 + tt >= 0) ? *(const unsigned*)(up + (long)tt * INW) : 0u; }
    float s0 = 0.f, s1 = 0.f;
#pragma unroll
    for (int i = 0; i < WIN - 1; ++i) { s0 += bflo(xv[i]); s1 += bfhi(xv[i]); }
#pragma unroll
    for (int jj = 0; jj < 16; ++jj) { const float x0 = bflo(xv[jj + WIN - 1]), x1 = bfhi(xv[jj + WIN - 1]); s0 += x0; s1 += x1;
        const int cn = tseq0 + jj + 1; const float ic = 1.0f / (float)(cn < WIN ? cn : WIN);
        *(LAS unsigned*)(PP + (tl0 + jj) * PPP + g * 64 + 2 * pair) = pk2(s0 * ic - x0, s1 * ic - x1);
        s0 -= bflo(xv[jj]); s1 -= bfhi(xv[jj]); }
}
__device__ __forceinline__ void pool_item(LAS unsigned char* lds, const bf16* U, bf16* Y, const float* poolw, const float* pscale, int item, int tid) {
    const int lane = tid & 63, w = __builtin_amdgcn_readfirstlane(tid >> 6), fr = lane & 15, fq = lane >> 4;
    LAS bf16* PP = (LAS bf16*)(lds + PP_OFF); LAS bf16* WT = (LAS bf16*)(lds + WT_OFF);
    for (int i = 0; i < 32; ++i) { const int idx = tid + 512 * i; const int g = idx >> 12, c = (idx >> 6) & 63, d = idx & 63; WT[(g * 64 + d) * SP + c] = (bf16)(pk2(poolw[idx], 0.f) & 0xffffu); }
    for (int hh = 0; hh < 2; ++hh) {
        const int R0 = item * 256 + hh * 128;
#pragma unroll 1
        for (int rr = 0; rr < 2; ++rr) { const int g = w & 3, tq = w >> 2, pair = lane & 31, sub = lane >> 5, tl0 = tq * 64 + sub * 32 + rr * 16;
          if (g == 0) pool_run<2>(PP, U, R0 + tl0, tl0, 0, pair); else if (g == 1) pool_run<4>(PP, U, R0 + tl0, tl0, 1, pair); else if (g == 2) pool_run<8>(PP, U, R0 + tl0, tl0, 2, pair); else pool_run<16>(PP, U, R0 + tl0, tl0, 3, pair); }
        __syncthreads();
#pragma unroll 1
        for (int g = 0; g < 4; ++g) { bf16x8 pf[2];
#pragma unroll
            for (int kk = 0; kk < 2; ++kk) pf[kk] = *(const LAS bf16x8*)(PP + (16 * w + fr) * PPP + g * 64 + kk * 32 + 8 * fq);
#pragma unroll
            for (int dt = 0; dt < 4; ++dt) { f32x4 acc = (f32x4){0.f, 0.f, 0.f, 0.f};
#pragma unroll
                for (int kk = 0; kk < 2; ++kk) { const bf16x8 wf = *(const LAS bf16x8*)(WT + (g * 64 + dt * 16 + fr) * SP + kk * 32 + 8 * fq); acc = MFMA16(wf, pf[kk], acc); }
                const int dcol = g * 64 + dt * 16 + 4 * fq; const f32x4 sc = *(const f32x4*)(pscale + dcol);
                u32x2 o; o.x = pk2(acc[0] * sc[0], acc[1] * sc[1]); o.y = pk2(acc[2] * sc[2], acc[3] * sc[3]);
                *(u32x2*)(Y + (size_t)(R0 + 16 * w + fr) * D + dcol) = o; } }
        __syncthreads();
    }
}

struct Args { const float* in[12]; float* out; unsigned char* ws; int ph_lo, ph_hi; };
static_assert(sizeof(Args) == 12 * 8 + 8 + 8 + 8, "Args has no padding");

__global__ void __launch_bounds__(NWAVES * 64, 2) mk_fwd(Args args) {
    extern __shared__ __attribute__((aligned(16))) unsigned char lds_raw[];
    LAS unsigned char* lds = (LAS unsigned char*)lds_raw;
    const int tid = threadIdx.x, lane = tid & 63, wave = __builtin_amdgcn_readfirstlane(tid >> 6);
    const int G = gridDim.x, bx = blockIdx.x, gw = bx * NWAVES + wave, ngw = G * NWAVES;
    unsigned char* ws = args.ws;
    float* X = args.out;
#define INPTRS(A) const float* norm_mix_g = (A).in[1]; const float* w_in = (A).in[2]; const float* pool_w = (A).in[3]; const float* pool_scale = (A).in[4]; \
    const float* hgrn_norm_g = (A).in[6]; const float* w_out = (A).in[7]; const float* norm_mlp_g = (A).in[8]; const float* w_up = (A).in[9]; const float* w_down = (A).in[10];
#define WSPTRS(wsb) bf16* WIN = (bf16*)((wsb) + WS_WIN); bf16* WOUT = (bf16*)((wsb) + WS_WOUT); bf16* WUP = (bf16*)((wsb) + WS_WUP); bf16* WDN = (bf16*)((wsb) + WS_WDN); \
    bf16* XB = (bf16*)((wsb) + WS_XB); bf16* Yb = (bf16*)((wsb) + WS_Y); bf16* U = (bf16*)((wsb) + WS_U); bf16* Hb = (bf16*)((wsb) + WS_U); \
    float* SEGS = (float*)((wsb) + WS_SEGS); float* SEGD = (float*)((wsb) + WS_SEGD); float* SS = (float*)((wsb) + WS_SS); float* LB = (float*)((wsb) + WS_LB);
    const int lo = args.ph_lo, hi = args.ph_hi;
#if MK_SINGLE
    cg::grid_group grid = cg::this_grid();
    volatile LAS unsigned* MISC = (volatile LAS unsigned*)(lds + MISC_OFF);
    if (tid < 32) MISC[tid] = 0u;
    __syncthreads();
    (void)xcd_barrier_post((unsigned*)(ws + WS_BAR), MISC);
#define SEAM(k) do { if ((k) + 1 < hi) { if ((k) == 0) grid.sync(); else { XcdBarrier xb_; xb_.bar = (unsigned*)(args.ws + WS_BAR); xb_.x = xb_xcc_id(); xb_.st = (volatile LAS unsigned*)(lds + MISC_OFF); xcd_barrier(xb_); } } } while (0)
#else
#define SEAM(k) do { } while (0)
#endif
#define IN(k) (lo <= (k) && (k) < hi)

    if (IN(0)) {
        WSPTRS(ws)
        const float* x_in = args.in[0]; const float* norm_mix_g = args.in[1]; const float* w_in = args.in[2]; const float* lb_logits = args.in[5];
        if (bx == 0) for (int ch = tid; ch < HW; ch += NWAVES * 64) {
            float l0 = lb_logits[ch], l1 = lb_logits[HW + ch], l2 = lb_logits[2 * HW + ch], l3 = lb_logits[3 * HW + ch];
            const float mx = fmaxf(fmaxf(l0, l1), fmaxf(l2, l3)); l0 = expf(l0 - mx); l1 = expf(l1 - mx); l2 = expf(l2 - mx); l3 = expf(l3 - mx);
            const float inv = 1.0f / (l0 + l1 + l2 + l3);
            LB[ch] = 0.f; LB[HW + ch] = l1 * inv; LB[2 * HW + ch] = (l1 + l2) * inv; LB[3 * HW + ch] = (l1 + l2 + l3) * inv; }
        (void)convert_one(lds, w_in, norm_mix_g, WIN, D, INW, 0, gw, ngw, wave, lane);
        for (int m = gw; m < M; m += ngw) {
            const f32x4* xr = (const f32x4*)(x_in + (size_t)m * D) + lane; f32x4 v[4]; float s = 0.f;
#pragma unroll
            for (int j = 0; j < 4; ++j) { v[j] = xr[64 * j]; s += (v[j][0] * v[j][0] + v[j][1] * v[j][1]) + (v[j][2] * v[j][2] + v[j][3] * v[j][3]); }
            s = wave_sum(s);
            f32x4* xo = (f32x4*)(X + (size_t)m * D) + lane; u32x2* bo = (u32x2*)(XB + (size_t)m * D) + lane;
#pragma unroll
            for (int j = 0; j < 4; ++j) { xo[64 * j] = v[j]; u32x2 o; o.x = pk2(v[j][0], v[j][1]); o.y = pk2(v[j][2], v[j][3]); bo[64 * j] = o; }
            if (lane < 16) SS[(size_t)m * 16 + lane] = (lane == 0) ? s : 0.f;
        }
        SEAM(0);
    }
#pragma unroll 1
    for (int l = 0; l < DEPTH; ++l) {
        const int pb = 1 + 6 * l;
        int tid_l = threadIdx.x; asm volatile("" : "+v"(tid_l));
        unsigned char* ws_l = ws; asm volatile("" : "+s"(ws_l));
        const int lane_l = tid_l & 63, wave_l = __builtin_amdgcn_readfirstlane(tid_l >> 6), gw_l = bx * NWAVES + wave_l;
        WSPTRS(ws_l)
        const Args* ap = (const Args*)__builtin_amdgcn_kernarg_segment_ptr(); asm volatile("" : "+s"(ap));
        INPTRS(*ap)
        float* X = ap->out;
        if (IN(pb)) {
            pg8::Gemm g{XB, WIN, M, INW, D}; pg8::StaticOrder S; S.init(M, INW, G, bx);
#if defined(DBG_EXP) && DBG_EXP == 1
            pg8::EpiAct E{U, INW, SS + (size_t)(l == 3 ? 0 : 2 * l) * M * 16, LB + l * HW, 1};
#elif defined(DBG_EXP) && DBG_EXP == 2
            pg8::EpiAct E{U, INW, SS + (size_t)(2 * l) * M * 16, LB + (l == 3 ? 2 : l) * HW, 1};
#else
            pg8::EpiAct E{U, INW, SS + (size_t)(2 * l) * M * 16, LB + l * HW, 1};
#endif
            pg8::gemm_phase<pg8::EpiAct, pg8::StaticOrder, true, true>(lds, g, S, E);
            SEAM(pb);
        }
        if (IN(pb + 1)) {
            for (int it = bx; it < NHITEMS + NPOOL; it += G) {
                if (it < NHITEMS) hgrn_item<false>(lds, U, Yb, SEGS, SEGD, hgrn_norm_g + l * HW, it, tid_l);
                else pool_item(lds, U, Yb, pool_w + (size_t)l * 16384, pool_scale + l * PW, it - NHITEMS, tid_l);
            }
            __syncthreads();
            __syncthreads();
            SEAM(pb + 1);
        }
        if (IN(pb + 2)) {
            for (int it = bx; it < NHITEMS; it += G) hgrn_item<true>(lds, U, Yb, SEGS, SEGD, hgrn_norm_g + l * HW, it, tid_l);
            { const bool spare = G > NHITEMS; const int cgw = spare ? (bx - NHITEMS) * NWAVES + wave_l : gw_l, cngw = spare ? (G - NHITEMS) * NWAVES : ngw;
              if (!spare || bx >= NHITEMS) { __syncthreads();
            int cb = convert_one(lds, w_out + (size_t)l * D * D, nullptr, WOUT, D, D, 0, cgw, cngw, wave_l, lane_l);
            cb = convert_one(lds, w_up + (size_t)l * D * FF, norm_mlp_g + l * D, WUP, D, FF, cb, cgw, cngw, wave_l, lane_l);
            cb = convert_one(lds, w_down + (size_t)l * FF * D, nullptr, WDN, FF, D, cb, cgw, cngw, wave_l, lane_l);
            if (l + 1 < DEPTH) cb = convert_one(lds, w_in + (size_t)(l + 1) * D * INW, norm_mix_g + (l + 1) * D, WIN, D, INW, cb, cgw, cngw, wave_l, lane_l);
              } }
            SEAM(pb + 2);
        }
        if (IN(pb + 3)) {
            pg8::Gemm g{Yb, WOUT, M, D, D}; pg8::StaticOrder S; S.init(M, D, G, bx);
            pg8::EpiResid E{X, XB, SS + (size_t)(2 * l + 1) * M * 16};
            pg8::gemm_phase<pg8::EpiResid, pg8::StaticOrder, true, true>(lds, g, S, E);
            SEAM(pb + 3);
        }
        if (IN(pb + 4)) {
            pg8::Gemm g{XB, WUP, M, FF, D}; pg8::StaticOrder S; S.init(M, FF, G, bx);
            pg8::EpiAct E{Hb, FF, SS + (size_t)(2 * l + 1) * M * 16, nullptr, 0};
            pg8::gemm_phase<pg8::EpiAct, pg8::StaticOrder, true, true>(lds, g, S, E);
            SEAM(pb + 4);
        }
        if (IN(pb + 5)) {
            pg8::Gemm g{Hb, WDN, M, D, FF}; pg8::StaticOrder S; S.init(M, D, G, bx);
            pg8::EpiResid E{X, XB, SS + (size_t)(2 * l + 2) * M * 16};
            pg8::gemm_phase<pg8::EpiResid, pg8::StaticOrder, true, true>(lds, g, S, E);
            SEAM(pb + 5);
        }
    }
    if (IN(NPHASES - 1)) {
        int tid_f = threadIdx.x; asm volatile("" : "+v"(tid_f));
        const int lane_f = tid_f & 63, gw_f = bx * NWAVES + __builtin_amdgcn_readfirstlane(tid_f >> 6);
        const float* ssf = (const float*)(args.ws + WS_SS) + (size_t)(2 * DEPTH) * M * 16; float* Xf = args.out;
        for (int m = gw_f; m < M; m += ngw) {
            const float rs = rsqrtf(wave_sum(lane_f < 16 ? ssf[(size_t)m * 16 + lane_f] : 0.f) * (1.0f / D) + EPS);
            f32x4* xr = (f32x4*)(Xf + (size_t)m * D) + lane_f; const f32x4* gr = (const f32x4*)args.in[11] + lane_f;
#pragma unroll
            for (int j = 0; j < 4; ++j) xr[64 * j] = xr[64 * j] * rs * gr[64 * j];
        }
    }
#undef IN
#undef SEAM
}

__global__ void dbg_digest4(const float* segs, const float* segd, const unsigned short* y, float* out, int n) { int i = blockIdx.x * blockDim.x + threadIdx.x; if (i >= n) return;
    const int ns = 180 * 16384; float v;
    if (i < 192 * 16384) { const int item = i / 16384; v = (item % 16 == 15) ? 0.f : segs[i]; } else if (i < 192 * 16384 + 192 * 128) { const int k = i - 192 * 16384; v = ((k / 128) % 16 == 15) ? 0.f : segd[k]; }
    else if (i < 4 * 1048576) v = 0.f; else { const int k = i - 4 * 1048576; const int r = k / 256, c = k % 256; v = (r < M) ? __uint_as_float((unsigned)y[(size_t)r * 1024 + c] << 16) : 0.f; }
    out[i] = v; }
__global__ void dbg_digest5(const unsigned short* u, float* out, int n) { int i = blockIdx.x * blockDim.x + threadIdx.x; if (i >= n) return; const int r = i / 1024, c = i % 1024;
    const unsigned short* p = u + (size_t)r * 3328 + c; float v = __uint_as_float((unsigned)p[0] << 16) + 2.f * __uint_as_float((unsigned)p[1024] << 16) + 3.f * __uint_as_float((unsigned)p[2048] << 16); if (c < 256) v += 4.f * __uint_as_float((unsigned)p[3072] << 16); out[i] = v; }
__global__ void dbg_digest6(const unsigned short* u, float* out, int n) { int i = blockIdx.x * blockDim.x + threadIdx.x; if (i >= n) return; const int r = i / 1024, c = i % 1024;
    out[i] = (c < 768) ? __uint_as_float((unsigned)u[(size_t)r * 3328 + 1024 + c] << 16) : 0.f; }
__global__ void dbg_digest(const unsigned short* src, float* out, int n) { int i = blockIdx.x * blockDim.x + threadIdx.x; if (i < n) out[i] = __uint_as_float((unsigned)src[i] << 16); }
extern "C" void kernel_launch(void* const* d_in, const int* in_sizes, int n_in, void* d_out, int out_size, void* d_ws, size_t ws_size, hipStream_t stream) {
    static int grid = 0;
    if (grid == 0) {
        if (n_in != 12 || in_sizes[0] != M * D || out_size != M * D || ws_size < WS_END) { fprintf(stderr, "kernel_launch: unexpected shapes (n_in %d, in0 %d, out %d, ws %zu)\n", n_in, n_in > 0 ? in_sizes[0] : -1, out_size, ws_size); grid = -1; return; }
        int dev = 0, cus = 0, per_cu = 0;
        if (hipGetDevice(&dev) != hipSuccess || hipDeviceGetAttribute(&cus, hipDeviceAttributeMultiprocessorCount, dev) != hipSuccess) { grid = -1; return; }
        if (hipFuncSetAttribute((const void*)mk_fwd, hipFuncAttributeMaxDynamicSharedMemorySize, LDS_BYTES) != hipSuccess) { fprintf(stderr, "kernel_launch: hipFuncSetAttribute failed\n"); grid = -1; return; }
        if (hipOccupancyMaxActiveBlocksPerMultiprocessor(&per_cu, (const void*)mk_fwd, NWAVES * 64, LDS_BYTES) != hipSuccess || per_cu < 1) { fprintf(stderr, "kernel_launch: occupancy query says %d\n", per_cu); per_cu = 1; }
        (void)hipGetLastError();
        grid = cus * (per_cu < 1 ? 1 : per_cu);
        if (grid > 256) grid = 256;
    }
    if (grid < 0) return;
    (void)hipMemsetAsync((char*)d_ws + WS_BAR, 0, BAR_ZERO_BYTES, stream);
    Args a{};
    for (int i = 0; i < 12; ++i) a.in[i] = (const float*)d_in[i];
    a.out = (float*)d_out; a.ws = (unsigned char*)d_ws;
#if MK_SINGLE
#ifdef DBG_STOP
    a.ph_lo = 0; a.ph_hi = DBG_STOP;
#else
    a.ph_lo = 0; a.ph_hi = NPHASES;
#endif
    void* kargs[] = {&a};
    hipError_t e = hipLaunchCooperativeKernel((const void*)mk_fwd, dim3(grid), dim3(NWAVES * 64), kargs, LDS_BYTES, stream);
    if (e != hipSuccess) fprintf(stderr, "kernel_launch: cooperative launch failed: %s (grid %d)\n", hipGetErrorString(e), grid);
#if defined(DBG_DIGEST) && DBG_DIGEST == 4
    hipLaunchKernelGGL(dbg_digest4, dim3(M * D / 256), dim3(256), 0, stream, (const float*)((char*)d_ws + WS_SEGS), (const float*)((char*)d_ws + WS_SEGD), (const unsigned short*)((char*)d_ws + WS_Y), (float*)d_out, M * D);
#elif defined(DBG_DIGEST) && DBG_DIGEST == 6
    hipLaunchKernelGGL(dbg_digest6, dim3(M * D / 256), dim3(256), 0, stream, (const unsigned short*)((char*)d_ws + WS_U), (float*)d_out, M * D);
#elif defined(DBG_DIGEST) && DBG_DIGEST == 5
    hipLaunchKernelGGL(dbg_digest5, dim3(M * D / 256), dim3(256), 0, stream, (const unsigned short*)((char*)d_ws + WS_U), (float*)d_out, M * D);
#elif defined(DBG_DIGEST)
    hipLaunchKernelGGL(dbg_digest, dim3(M * D / 256), dim3(256), 0, stream, (const unsigned short*)((char*)d_ws + (DBG_DIGEST == 1 ? WS_Y : (DBG_DIGEST == 2 ? WS_U : WS_XB))), (float*)d_out, M * D);
#endif
#else
#ifndef DBG_STOP
#define DBG_STOP NPHASES
#endif
    for (int p = 0; p < DBG_STOP; ++p) { a.ph_lo = p; a.ph_hi = p + 1; hipLaunchKernelGGL(mk_fwd, dim3(grid), dim3(NWAVES * 64), LDS_BYTES, stream, a); }
#if defined(DBG_DIGEST) && DBG_DIGEST == 4
    hipLaunchKernelGGL(dbg_digest4, dim3(M * D / 256), dim3(256), 0, stream, (const float*)((char*)d_ws + WS_SEGS), (const float*)((char*)d_ws + WS_SEGD), (const unsigned short*)((char*)d_ws + WS_Y), (float*)d_out, M * D);
#elif defined(DBG_DIGEST)
    hipLaunchKernelGGL(dbg_digest, dim3(M * D / 256), dim3(256), 0, stream, (const unsigned short*)((char*)d_ws + (DBG_DIGEST == 1 ? WS_Y : WS_U)), (float*)d_out, M * D);
#endif
#endif
}
```

```cpp
#include <hip/hip_runtime.h>
#include <hip/hip_cooperative_groups.h>
#include <cstdio>
#include <cstdint>
namespace cg = cooperative_groups;
namespace pg8 {
#define PG8_LAS __attribute__((address_space(3)))
typedef unsigned short bf16_t;
typedef short bf16x8 __attribute__((ext_vector_type(8)));
typedef float f32x4 __attribute__((ext_vector_type(4)));
typedef unsigned u32x4 __attribute__((ext_vector_type(4)));
constexpr int BM = 256, BK = 64, HALF = 128, HTB = HALF * BK * 2  , STAGE_BYTES = 8 * HTB, NXCD = 8, WGM = 8;

__host__ __device__ __forceinline__ int lds_byte(int r, int c) { const int st = (r >> 4) * 2 + (c >> 5), rr = r & 15, cc = c & 31, ob = rr * 64 + cc * 2; return st * 1024 + (ob ^ (((ob >> 9) & 1) << 5)); }
__host__ __device__ __forceinline__ void stage_rc(int b, int& R, int& C) { const int st = b / 1024, sb = b % 1024, swz = sb ^ (((sb >> 9) & 1) << 5); R = (st >> 1) * 16 + swz / 64; C = (st & 1) * 32 + (swz % 64) / 2; }
__host__ __device__ __forceinline__ int perm32(int rho) { const int n = rho >> 4, i = rho & 15; return 8 * (i >> 2) + 4 * n + (i & 3); }

struct Unit { int pm, pn; };
struct Gemm { const bf16_t* A; const bf16_t* Bt; int M, N, K; };

struct StaticOrder {
    int nM, nN, nwg, G, c;
    __host__ __device__ void init(int M, int N, int G_, int c_) { nM = M / BM; nN = N / BM; nwg = nM * nN; G = G_; c = c_; }
    __host__ __device__ bool next(int i, Unit& u) const {
        const long L = (long)i * G + c; if (L >= nwg) return false;
        int wgid = (int)L; { const int q = nwg / NXCD, r = nwg % NXCD, xcd = wgid % NXCD, off = wgid / NXCD; wgid = (xcd < r ? xcd * (q + 1) : r * (q + 1) + (xcd - r) * q) + off; }
        const int nig = WGM * nN, gid = wgid / nig, fm = gid * WGM, gsz = (nM - fm) < WGM ? (nM - fm) : WGM;
        u.pm = fm + ((wgid % nig) % gsz); u.pn = (wgid % nig) / gsz; return true;
    }
    __device__ __forceinline__ void a_ready(const Unit&) const {}
    __device__ __forceinline__ void done(const Unit&) const {}
};

struct OffsetOrder {
    StaticOrder base; int pn0;
    __device__ __forceinline__ bool next(int i, Unit& u) const { if (!base.next(i, u)) return false; u.pn += pn0; return true; }
    __device__ __forceinline__ void a_ready(const Unit&) const {}
    __device__ __forceinline__ void done(const Unit&) const {}
};
struct FlexOrder {
    StaticOrder base; int pn0, single, pm1, pn1;
    __device__ __forceinline__ bool next(int i, Unit& u) const { if (single) { if (i > 0) return false; u.pm = pm1; u.pn = pn1; return true; } if (!base.next(i, u)) return false; u.pn += pn0; return true; }
    __device__ __forceinline__ void a_ready(const Unit&) const {}
    __device__ __forceinline__ void done(const Unit&) const {}
};
struct SingleUnit {
    int pm, pn;
    __device__ __forceinline__ bool next(int i, Unit& u) const { if (i > 0) return false; u.pm = pm; u.pn = pn; return true; }
    __device__ __forceinline__ void a_ready(const Unit&) const {}
    __device__ __forceinline__ void done(const Unit&) const {}
};
__device__ __forceinline__ unsigned cvt_pk_bf16(float lo, float hi) { unsigned r; asm volatile("v_cvt_pk_bf16_f32 %0, %1, %2" : "=v"(r) : "v"(lo), "v"(hi)); return r; }
typedef float f32x2 __attribute__((ext_vector_type(2)));

typedef unsigned u32x2 __attribute__((ext_vector_type(2)));
__device__ __forceinline__ float fast_rcp(float x) { return __builtin_amdgcn_rcpf(x); }
__device__ __forceinline__ float silu_f(float v) { return v * fast_rcp(1.0f + __expf(-v)); }
struct EpiAct {
    static constexpr bool PERM = true, AFTER_DRAIN = false;
    bf16_t* O; int ldc; const float* ss; const float* lb; int is_in;
    __device__ __forceinline__ void operator()(const f32x4 (&acc)[2][2][4][2], const Unit& u, int wr, int wc, int fr, int fq) const {
        const int row0 = u.pm * BM + wr * 64 + fr; const int col0 = u.pn * BM + wc * 32 + 8 * fq;
        const __amdgpu_buffer_rsrc_t orsrc = __builtin_amdgcn_make_buffer_rsrc((void*)O, 0, 0x7ffffff0, 0x00020000);
        int mode = 3;
        if (is_in) { const int t = u.pn; mode = (t == 0) ? 0 : (t <= 3 ? 1 : (t <= 6 ? 2 : (t <= 9 ? 0 : 1))); }
        float rsv[2][4];
        { f32x4 pv[2][4];
#pragma unroll
          for (int ai = 0; ai < 2; ++ai)
#pragma unroll
              for (int m = 0; m < 4; ++m) pv[ai][m] = *(const f32x4*)(ss + (size_t)(row0 + ai * HALF + m * 16) * 16 + 4 * fq);
          f32x4 lbv[2][2];
#pragma unroll
          for (int bj = 0; bj < 2; ++bj)
#pragma unroll
              for (int n = 0; n < 2; ++n) lbv[bj][n] = (mode == 2) ? *(const f32x4*)(lb + (col0 - 1024) + bj * HALF + 4 * n) : (f32x4){0.f, 0.f, 0.f, 0.f};
#pragma unroll
          for (int ai = 0; ai < 2; ++ai)
#pragma unroll
              for (int m = 0; m < 4; ++m) { float t = (pv[ai][m][0] + pv[ai][m][1]) + (pv[ai][m][2] + pv[ai][m][3]); t += __shfl_xor(t, 16); t += __shfl_xor(t, 32); rsv[ai][m] = rsqrtf(t * (1.0f / 1024.0f) + 1e-5f); }
#pragma unroll
        for (int ai = 0; ai < 2; ++ai)
#pragma unroll
            for (int m = 0; m < 4; ++m) { const int r = row0 + ai * HALF + m * 16; const float rs = rsv[ai][m];
                bf16_t* rowp = O + (size_t)r * ldc + col0;
#pragma unroll
                for (int bj = 0; bj < 2; ++bj) { f32x4 v[2]; v[0] = acc[ai][bj][m][0] * rs; v[1] = acc[ai][bj][m][1] * rs;
                    if (mode == 1) {
#pragma unroll
                        for (int n = 0; n < 2; ++n)
#pragma unroll
                            for (int e = 0; e < 4; ++e) v[n][e] = silu_f(v[n][e]);
                    } else if (mode == 2) {
#pragma unroll
                        for (int n = 0; n < 2; ++n)
#pragma unroll
                            for (int e = 0; e < 4; ++e) { const float s = fast_rcp(1.0f + __expf(-v[n][e])); const float l = lbv[bj][n][e]; v[n][e] = __logf(l + (1.0f - l) * s); }
                    } else if (mode == 3) {
#pragma unroll
                        for (int n = 0; n < 2; ++n)
#pragma unroll
                            for (int e = 0; e < 4; ++e) { const float t = fmaxf(v[n][e], 0.f); v[n][e] = t * t; }
                    }
                    u32x4 w; w.x = cvt_pk_bf16(v[0][0], v[0][1]); w.y = cvt_pk_bf16(v[0][2], v[0][3]); w.z = cvt_pk_bf16(v[1][0], v[1][1]); w.w = cvt_pk_bf16(v[1][2], v[1][3]);
                    __builtin_amdgcn_raw_buffer_store_b128(w, orsrc, (unsigned)(((size_t)r * ldc + col0 + bj * HALF) * 2), 0, 16); } }
        }
    }
};
struct EpiResid {
    static constexpr bool PERM = true, AFTER_DRAIN = false;
    bf16_t* XB; float* ss;
    __device__ __forceinline__ void operator()(const f32x4 (&acc)[2][2][4][2], const Unit& u, int wr, int wc, int fr, int fq) const {
        const int col0 = u.pn * BM + wc * 32 + 8 * fq;
        u32x4 xo[2][4][2];
#pragma unroll
        for (int ai = 0; ai < 2; ++ai)
#pragma unroll
            for (int m = 0; m < 4; ++m)
#pragma unroll
                for (int bj = 0; bj < 2; ++bj) xo[ai][m][bj] = *(const u32x4*)(XB + (size_t)(u.pm * BM + ai * HALF + wr * 64 + m * 16 + fr) * 1024 + col0 + bj * HALF);
#pragma unroll
        for (int ai = 0; ai < 2; ++ai)
#pragma unroll
            for (int m = 0; m < 4; ++m) { const int r = u.pm * BM + ai * HALF + wr * 64 + m * 16 + fr; const size_t off = (size_t)r * 1024 + col0; float sq = 0.f;
#pragma unroll
                for (int bj = 0; bj < 2; ++bj) { const u32x4 x = xo[ai][m][bj]; const f32x4 a = acc[ai][bj][m][0], b = acc[ai][bj][m][1];
                    const float o0 = __uint_as_float(x.x << 16) + a[0], o1 = __uint_as_float(x.x & 0xffff0000u) + a[1], o2 = __uint_as_float(x.y << 16) + a[2], o3 = __uint_as_float(x.y & 0xffff0000u) + a[3];
                    const float o4 = __uint_as_float(x.z << 16) + b[0], o5 = __uint_as_float(x.z & 0xffff0000u) + b[1], o6 = __uint_as_float(x.w << 16) + b[2], o7 = __uint_as_float(x.w & 0xffff0000u) + b[3];
                    sq += ((o0 * o0 + o1 * o1) + (o2 * o2 + o3 * o3)) + ((o4 * o4 + o5 * o5) + (o6 * o6 + o7 * o7));
                    u32x4 w; w.x = cvt_pk_bf16(o0, o1); w.y = cvt_pk_bf16(o2, o3); w.z = cvt_pk_bf16(o4, o5); w.w = cvt_pk_bf16(o6, o7); *(u32x4*)(XB + off + bj * HALF) = w; }
                sq += __shfl_xor(sq, 16); sq += __shfl_xor(sq, 32);
                if (fq == 0) ss[(size_t)r * 16 + u.pn * 4 + wc] = sq;
            }
    }
};

template <class Epi, class Sched, bool ALIGN_EPI = false, bool SP2 = false>
__device__ __forceinline__ void gemm_phase(PG8_LAS unsigned char* lds, const Gemm g, const Sched& S, const Epi& E) {
    int tid_ = threadIdx.x; asm volatile("" : "+v"(tid_));
    const int tid = tid_, wid = __builtin_amdgcn_readfirstlane(tid >> 6), lane = tid & 63, wr = wid >> 2, wc = wid & 3, fr = lane & 15, fq = lane >> 4;
    const int K = g.K, nt = K / BK;
    unsigned voffA[2], voffB[2];
#pragma unroll
    for (int i = 0; i < 2; ++i) { int R, C; stage_rc(tid * 16 + i * 8192, R, C); const int Rb = Epi::PERM ? ((R & ~31) + perm32(R & 31)) : R;
        voffA[i] = (unsigned)(R * K + C) * 2u; voffB[i] = (unsigned)(Rb * K + C) * 2u; }
    const size_t kstep = (size_t)(BK * 2);
    const size_t hstep = (size_t)HALF * K * 2;
    const size_t tstep = 2 * hstep;
    const unsigned ldsw = (unsigned)wid * 1024u;
    const int aoff = lds_byte(wr * 64 + fr, fq * 8), boff = lds_byte(wc * 32 + fr, fq * 8);
#define PG8_SA(b, h) (((b) * 2 + (h)) * HTB)
#define PG8_SB(b, h) ((4 + (b) * 2 + (h)) * HTB)
#define PG8_STAGE(bufoff, gbase, voff) do { _Pragma("unroll") for (int _i = 0; _i < 2; ++_i) \
        __builtin_amdgcn_global_load_lds((const unsigned*)((const char*)(gbase) + (voff)[_i]), (PG8_LAS unsigned*)(lds + (bufoff) + ldsw + _i * 8192), 16, 0, 0); } while (0)
#define PG8_LDA(dst, b, h) do { _Pragma("unroll") for (int m = 0; m < 4; ++m) _Pragma("unroll") for (int k = 0; k < 2; ++k) dst[m][k] = *(const PG8_LAS bf16x8*)(lds + PG8_SA(b, h) + aoff + m * 2048 + k * 1024); } while (0)
#define PG8_LDB(dst, b, h) do { _Pragma("unroll") for (int n = 0; n < 2; ++n) _Pragma("unroll") for (int k = 0; k < 2; ++k) dst[n][k] = *(const PG8_LAS bf16x8*)(lds + PG8_SB(b, h) + boff + n * 2048 + k * 1024); } while (0)
#define PG8_MMA(ai, bj, At, Bt) do { __builtin_amdgcn_s_setprio(1); _Pragma("unroll") for (int m = 0; m < 4; ++m) _Pragma("unroll") for (int n = 0; n < 2; ++n) _Pragma("unroll") for (int k = 0; k < 2; ++k) \
        acc[ai][bj][m][n] = __builtin_amdgcn_mfma_f32_16x16x32_bf16(Bt[n][k], At[m][k], acc[ai][bj][m][n], 0, 0, 0); __builtin_amdgcn_s_setprio(0); } while (0)
#define PG8_WAIT_V(n) asm volatile("s_waitcnt vmcnt(" #n ")" ::: "memory")
#define PG8_WAIT_L(n) asm volatile("s_waitcnt lgkmcnt(" #n ")" ::: "memory")
#define PG8_BAR __builtin_amdgcn_s_barrier()
#define PG8_SCHED __builtin_amdgcn_sched_barrier(0)
    Unit cur, nxt; int ui = 0;
    if (!S.next(0, cur)) return;
    f32x4 acc[2][2][4][2];
#pragma unroll
    for (int a = 0; a < 2; ++a)
#pragma unroll
        for (int b = 0; b < 2; ++b)
#pragma unroll
            for (int m = 0; m < 4; ++m)
#pragma unroll
                for (int n = 0; n < 2; ++n) acc[a][b][m][n] = (f32x4){0.f, 0.f, 0.f, 0.f};
    bf16x8 At[4][2], B0[2][2], B1[2][2];
    const char* cA = (const char*)g.A + (size_t)cur.pm * tstep; const char* cB = (const char*)g.Bt + (size_t)cur.pn * tstep;
    S.a_ready(cur);
    if constexpr (SP2) {
        PG8_STAGE(PG8_SB(0, 0), cB, voffB); PG8_STAGE(PG8_SB(0, 1), cB + hstep, voffB); PG8_STAGE(PG8_SA(0, 0), cA, voffA); PG8_STAGE(PG8_SA(0, 1), cA + hstep, voffA);
        if (wr == 1) PG8_BAR;
        PG8_WAIT_V(2); PG8_BAR;
        PG8_STAGE(PG8_SB(1, 0), cB + kstep, voffB); PG8_STAGE(PG8_SA(1, 0), cA + kstep, voffA); PG8_STAGE(PG8_SB(1, 1), cB + hstep + kstep, voffB);
        PG8_WAIT_V(6); PG8_BAR;
    } else {
        PG8_STAGE(PG8_SB(0, 0), cB, voffB); PG8_STAGE(PG8_SA(0, 0), cA, voffA); PG8_STAGE(PG8_SB(0, 1), cB + hstep, voffB); PG8_STAGE(PG8_SA(0, 1), cA + hstep, voffA);
        if (wr == 1) PG8_BAR;
        PG8_WAIT_V(4); PG8_BAR;
        PG8_STAGE(PG8_SB(1, 0), cB + kstep, voffB); PG8_STAGE(PG8_SA(1, 0), cA + kstep, voffA); PG8_STAGE(PG8_SB(1, 1), cB + hstep + kstep, voffB);
        PG8_WAIT_V(6); PG8_BAR;
    }
    for (;;) {
        const bool has_next = S.next(ui + 1, nxt);
        const char* nA = has_next ? (const char*)g.A + (size_t)nxt.pm * tstep : cA; const char* nB = has_next ? (const char*)g.Bt + (size_t)nxt.pn * tstep : cB;
        for (int t = 0; t < nt; t += 2) {
            const bool last = (t == nt - 2);
            const char* a1 = cA + (size_t)(t + 1) * kstep;
            const char* a2 = last ? nA : cA + (size_t)(t + 2) * kstep; const char* b2 = last ? nB : cB + (size_t)(t + 2) * kstep;
            const char* a3 = a2 + kstep; const char* b3 = b2 + kstep;
            if (last && has_next) S.a_ready(nxt);
            if constexpr (SP2) {
            PG8_LDB(B0, 0, 0); PG8_LDB(B1, 0, 1); PG8_SCHED; PG8_LDA(At, 0, 0); PG8_STAGE(PG8_SA(1, 1), a1 + hstep, voffA);
            PG8_WAIT_V(8); PG8_WAIT_L(0); PG8_BAR; PG8_MMA(0, 0, At, B0); PG8_MMA(0, 1, At, B1); PG8_BAR; PG8_SCHED;
            PG8_LDA(At, 0, 1); PG8_STAGE(PG8_SB(0, 0), b2, voffB); PG8_STAGE(PG8_SB(0, 1), b2 + hstep, voffB); PG8_STAGE(PG8_SA(0, 0), a2, voffA);
            PG8_WAIT_V(8); PG8_WAIT_L(0); PG8_BAR; PG8_MMA(1, 0, At, B0); PG8_MMA(1, 1, At, B1); PG8_BAR; PG8_SCHED;
            PG8_LDB(B0, 1, 0); PG8_LDB(B1, 1, 1); PG8_SCHED; PG8_LDA(At, 1, 0); PG8_STAGE(PG8_SA(0, 1), a2 + hstep, voffA);
            PG8_WAIT_V(8); PG8_WAIT_L(0); PG8_BAR; PG8_MMA(0, 0, At, B0); PG8_MMA(0, 1, At, B1); PG8_BAR; PG8_SCHED;
            PG8_LDA(At, 1, 1); PG8_STAGE(PG8_SB(1, 0), b3, voffB); PG8_STAGE(PG8_SB(1, 1), b3 + hstep, voffB); PG8_STAGE(PG8_SA(1, 0), a3, voffA);
            PG8_WAIT_V(8); PG8_WAIT_L(0); PG8_BAR; PG8_MMA(1, 0, At, B0); PG8_MMA(1, 1, At, B1); PG8_BAR; PG8_SCHED;
            } else {
            PG8_LDB(B0, 0, 0); PG8_SCHED; PG8_LDA(At, 0, 0); PG8_STAGE(PG8_SA(1, 1), a1 + hstep, voffA);
            PG8_WAIT_L(8); PG8_BAR; PG8_WAIT_L(0); PG8_MMA(0, 0, At, B0); PG8_BAR; PG8_SCHED;
            PG8_LDB(B1, 0, 1); PG8_STAGE(PG8_SB(0, 0), b2, voffB);
            PG8_BAR; PG8_WAIT_L(0); PG8_MMA(0, 1, At, B1); PG8_BAR;
            PG8_LDA(At, 0, 1); PG8_STAGE(PG8_SA(0, 0), a2, voffA);
            PG8_BAR; PG8_WAIT_L(0); PG8_MMA(1, 0, At, B0); PG8_BAR; PG8_SCHED;
            PG8_STAGE(PG8_SB(0, 1), b2 + hstep, voffB);
            PG8_WAIT_V(6); PG8_BAR; PG8_MMA(1, 1, At, B1); PG8_BAR;
            PG8_LDB(B0, 1, 0); PG8_SCHED; PG8_LDA(At, 1, 0); PG8_STAGE(PG8_SA(0, 1), a2 + hstep, voffA);
            PG8_WAIT_L(8); PG8_BAR; PG8_WAIT_L(0); PG8_MMA(0, 0, At, B0); PG8_BAR; PG8_SCHED;
            PG8_LDB(B1, 1, 1); PG8_STAGE(PG8_SB(1, 0), b3, voffB);
            PG8_BAR; PG8_WAIT_L(0); PG8_MMA(0, 1, At, B1); PG8_BAR;
            PG8_LDA(At, 1, 1); PG8_STAGE(PG8_SA(1, 0), a3, voffA);
            PG8_BAR; PG8_WAIT_L(0); PG8_MMA(1, 0, At, B0); PG8_BAR; PG8_SCHED;
            PG8_STAGE(PG8_SB(1, 1), b3 + hstep, voffB);
            PG8_WAIT_V(6); PG8_BAR; PG8_MMA(1, 1, At, B1); PG8_BAR;
            }
        }
        if constexpr (ALIGN_EPI) { if (wr == 0) PG8_BAR; }
        if constexpr (!Epi::AFTER_DRAIN) { E(acc, cur, wr, wc, fr, fq); S.done(cur); }
        if (!has_next) break;
#pragma unroll
        for (int a = 0; a < 2; ++a)
#pragma unroll
            for (int b = 0; b < 2; ++b)
#pragma unroll
                for (int m = 0; m < 4; ++m)
#pragma unroll
                    for (int n = 0; n < 2; ++n) acc[a][b][m][n] = (f32x4){0.f, 0.f, 0.f, 0.f};
        cur = nxt; cA = nA; cB = nB; ++ui;
        if constexpr (ALIGN_EPI) { if (wr == 1) PG8_BAR; }
    }
    PG8_WAIT_V(0);
    if constexpr (!ALIGN_EPI) { if (wr == 0) PG8_BAR; }
    PG8_BAR;
    if constexpr (Epi::AFTER_DRAIN) { E.fused(acc, cur, wr, wc, fr, fq, lds, wid, lane); S.done(cur); }
#undef PG8_SA
#undef PG8_SB
#undef PG8_STAGE
#undef PG8_LDA
#undef PG8_LDB
#undef PG8_MMA
#undef PG8_WAIT_V
#undef PG8_WAIT_L
#undef PG8_BAR
#undef PG8_SCHED
}
}

#ifndef MK_SINGLE
#define MK_SINGLE 1
#endif
constexpr int NWAVES = 8;
constexpr int M = 16384, D = 1024, INW = 3328, FF = 4096, SEQ = 8192, NH = 6, HD = 128, PW = 256, DEPTH = 4, HW = 768;
constexpr int SEGL = 512, NSEG = SEQ / SEGL, NCH = SEGL / 64, NHITEMS = 2 * NH * NSEG;
constexpr int NPOOL = M / 256;
constexpr float EPS = 1e-5f;
constexpr int NPHASES = 2 + 5 * DEPTH;
constexpr size_t MiB = 1u << 20;
constexpr size_t WS_BAR = 0, BAR_ZERO_BYTES = 16384 + 256 * 256;
constexpr size_t WS_PFLAG = 16384;
constexpr size_t WS_LB = 1 * MiB;
constexpr size_t WS_WIN = 2 * MiB, WS_WOUT = 9 * MiB, WS_WUP = 11 * MiB, WS_WDN = 19 * MiB;
constexpr size_t WS_XB = 27 * MiB, WS_Y = 59 * MiB;
constexpr size_t WS_SEGS = 91 * MiB, WS_SEGD = 103 * MiB;
constexpr size_t WS_U = 104 * MiB;
constexpr size_t WS_SS = 232 * MiB;
constexpr size_t WS_WIN2 = 241 * MiB;
constexpr size_t WS_END = 248 * MiB;
static_assert(WS_SS + 9 * (size_t)M * 64 <= WS_END && WS_WIN + (size_t)INW * D * 2 <= WS_WOUT && WS_SEGS + (size_t)NHITEMS * 65536 <= WS_SEGD && WS_U + (size_t)M * FF * 2 <= WS_SS && WS_SS + 9 * (size_t)M * 64 <= WS_WIN2 && WS_WIN2 + (size_t)INW * D * 2 <= WS_END, "ws map");
constexpr int LDS_BYTES = 147456;
constexpr int MISC_OFF = 131072;
constexpr int QP = 136, SP = 72, OP = 132;
constexpr int Q_OFF = 0, KT_OFF = 17408, OB_OFF = 0  , KH_OFF = 34816, VT_OFF = 53248, ST_OFF = 71680, PM_OFF = 106496, TOT_OFF = 115712, DV_OFF = 119808, DS_OFF = 120320;
static_assert(64 * OP * 4 <= KH_OFF && DS_OFF + 512 <= 131072, "mixer LDS map");
constexpr int PPP = 264;
constexpr int PP_OFF = 0, WT_OFF = 128 * PPP * 2;
static_assert(WT_OFF + 256 * SP * 2 <= 131072, "pool LDS map");

#define LAS __attribute__((address_space(3)))
#define GAS __attribute__((address_space(1)))
typedef unsigned short bf16;
typedef float f32x4 __attribute__((ext_vector_type(4)));
typedef float f32x2 __attribute__((ext_vector_type(2)));
typedef short bf16x8 __attribute__((ext_vector_type(8)));
typedef unsigned u32x4 __attribute__((ext_vector_type(4)));
typedef unsigned u32x2 __attribute__((ext_vector_type(2)));
typedef __bf16 bf16x2_t __attribute__((ext_vector_type(2)));
__device__ __forceinline__ unsigned pk2(float lo, float hi) { f32x2 v = {lo, hi}; bf16x2_t b = __builtin_convertvector(v, bf16x2_t); return __builtin_bit_cast(unsigned, b); }
__device__ __forceinline__ float bflo(unsigned u) { return __uint_as_float(u << 16); }
__device__ __forceinline__ float bfhi(unsigned u) { return __uint_as_float(u & 0xffff0000u); }
__device__ __forceinline__ float wave_sum(float v) {
#pragma unroll
    for (int o = 1; o < 64; o <<= 1) v += __shfl_xor(v, o);
    return v;
}
#define MFMA16(a, b, c) __builtin_amdgcn_mfma_f32_16x16x32_bf16((a), (b), (c), 0, 0, 0)

__device__ __forceinline__ void transpose_load(const float* W, int K, int N, int item, int lane, f32x4 (&v)[8]) {
    const int nblk = N / 32, kb = item / nblk, nb = item % nblk, k0 = 64 * kb, n0 = 32 * nb;
    const int kr = lane >> 3, nq = lane & 7;
    const GAS float* Wg = (const GAS float*)W + (size_t)(k0 + kr) * N + n0 + 4 * nq;
#pragma unroll
    for (int i = 0; i < 8; ++i) v[i] = *(const GAS f32x4*)(Wg + (size_t)(8 * i) * N);
}
__device__ __forceinline__ void transpose_finish(f32x4 (&v)[8], const float* g, int K, int N, bf16* WT, LAS float* scr, int item, int lane) {
    const int nblk = N / 32, kb = item / nblk, nb = item % nblk, k0 = 64 * kb, n0 = 32 * nb;
    const int kr = lane >> 3, nq = lane & 7;
    if (g) {
#pragma unroll
        for (int i = 0; i < 8; ++i) v[i] = v[i] * g[k0 + 8 * i + kr];
    }
#pragma unroll
    for (int i = 0; i < 8; ++i) { LAS float* d = scr + (8 * i + kr) * 33 + 4 * nq; d[0] = v[i][0]; d[1] = v[i][1]; d[2] = v[i][2]; d[3] = v[i][3]; }
    asm volatile("s_waitcnt lgkmcnt(0)" ::: "memory");
    const int c = lane & 7;
#pragma unroll
    for (int j = 0; j < 4; ++j) { const int n = (lane >> 3) + 8 * j; const LAS float* s = scr + (8 * c) * 33 + n;
        u32x4 o; o.x = pk2(s[0 * 33], s[1 * 33]); o.y = pk2(s[2 * 33], s[3 * 33]); o.z = pk2(s[4 * 33], s[5 * 33]); o.w = pk2(s[6 * 33], s[7 * 33]);
        *(GAS u32x4*)(WT + (size_t)(n0 + n) * K + k0 + 8 * c) = o; }
    asm volatile("s_waitcnt lgkmcnt(0)" ::: "memory");
}
__device__ __forceinline__ int convert_one(LAS unsigned char* lds, const float* W, const float* g, bf16* WT, int K, int N, int base, int gw, int ngw, int wave, int lane) {
    LAS float* scr = (LAS float*)(lds + wave * 16384);
    const int nit = (K / 64) * (N / 32);
    int it = (gw - base % ngw + ngw) % ngw;
#pragma unroll 1
    for (; it < nit; it += 4 * ngw) {
        f32x4 va[8], vb[8], vc[8], vd[8];
        const int i1 = it + ngw, i2 = it + 2 * ngw, i3 = it + 3 * ngw;
        transpose_load(W, K, N, it, lane, va);
        if (i1 < nit) transpose_load(W, K, N, i1, lane, vb);
        if (i2 < nit) transpose_load(W, K, N, i2, lane, vc);
        if (i3 < nit) transpose_load(W, K, N, i3, lane, vd);
        transpose_finish(va, g, K, N, WT, scr, it, lane);
        if (i1 < nit) transpose_finish(vb, g, K, N, WT, scr, i1, lane);
        if (i2 < nit) transpose_finish(vc, g, K, N, WT, scr, i2, lane);
        if (i3 < nit) transpose_finish(vd, g, K, N, WT, scr, i3, lane);
    }
    return base + nit;
}

#define XB_TMO      128
#define XB_XCNT(j)  (256  + 64 * (j))
#define XB_XSUB(j)  (1280 + 64 * (j))
#define XB_XGEN(j)  (2304 + 64 * (j))
#define XB_TOP      3328
#define XB_TOPGEN   3392
#define XCD_BAR_WORDS 3456
#define XB_SPIN_CAP (1u << 18)

__device__ __forceinline__ unsigned xb_ld(unsigned* p)              { return __hip_atomic_load(p, __ATOMIC_RELAXED, __HIP_MEMORY_SCOPE_AGENT); }
__device__ __forceinline__ unsigned xb_add(unsigned* p, unsigned v) { return __hip_atomic_fetch_add(p, v, __ATOMIC_RELAXED, __HIP_MEMORY_SCOPE_AGENT); }
__device__ __forceinline__ unsigned xb_xcc_id() { return (unsigned)__builtin_amdgcn_s_getreg((3 << 11) | 20) & 0xFu; }
#define XB_SPIN(cond, bar) do { unsigned _sp = 0; while (cond) { __builtin_amdgcn_s_sleep(1); \
    if ((++_sp & 255u) == 0u) { if (xb_ld(&(bar)[XB_TMO])) break; if (_sp > XB_SPIN_CAP) { atomicAdd(&(bar)[XB_TMO], 1u); break; } } } } while (0)

struct XcdBarrier {
    unsigned* bar; unsigned x;
    volatile LAS unsigned* st;
};

__device__ __forceinline__ XcdBarrier xcd_barrier_post(unsigned* bar, volatile LAS unsigned* st) {
    XcdBarrier b; b.bar = bar; b.x = xb_xcc_id(); b.st = st;
    if (threadIdx.x == 0) (void)xb_add(&bar[XB_XCNT(b.x)], 1u);
    return b;
}
__device__ __forceinline__ void xcd_barrier_complete(unsigned* bar, unsigned x, unsigned& nloc, unsigned& nx) {
    const unsigned G = gridDim.x * gridDim.y * gridDim.z;
    unsigned sum, cnt, mine, sp = 0u;
    for (;;) {
        sum = 0u; cnt = 0u; mine = 0u;
#pragma unroll
        for (unsigned j = 0; j < 16; ++j) { const unsigned c = xb_ld(&bar[XB_XCNT(j)]); sum += c; cnt += (c > 0u) ? 1u : 0u; mine = (j == x) ? c : mine; }
        if (sum == G) break;
        __builtin_amdgcn_s_sleep(1);
        if ((++sp & 255u) == 0u) { if (xb_ld(&bar[XB_TMO])) break; if (sp > XB_SPIN_CAP) { atomicAdd(&bar[XB_TMO], 1u); break; } }
    }
    nloc = mine > 0u ? mine : 1u; nx = cnt > 0u ? cnt : 1u;
}

__device__ __forceinline__ void xcd_barrier(const XcdBarrier& b) {
    asm volatile("s_waitcnt vmcnt(0)" ::: "memory");
    __syncthreads();
    if (threadIdx.x == 0) {
        unsigned* bar = b.bar;
        __builtin_amdgcn_s_waitcnt(0);
        unsigned nloc = b.st[0], nx = b.st[1];
        if (nloc == 0u) { xcd_barrier_complete(bar, b.x, nloc, nx); b.st[0] = nloc; b.st[1] = nx; }
        const unsigned old = xb_add(&bar[XB_XSUB(b.x)], 1u);
        const unsigned gen = old / nloc;
        if (old + 1u == (gen + 1u) * nloc) {
            __builtin_amdgcn_fence(__ATOMIC_RELEASE, "agent");
            asm volatile("s_waitcnt vmcnt(0)" ::: "memory");
            const unsigned og = xb_add(&bar[XB_TOP], 1u);
            const unsigned tg = og / nx;
            if (og + 1u == (tg + 1u) * nx) xb_add(&bar[XB_TOPGEN], 1u);
            else XB_SPIN(xb_ld(&bar[XB_TOPGEN]) == tg, bar);
            __builtin_amdgcn_fence(__ATOMIC_ACQUIRE, "agent");
            xb_add(&bar[XB_XGEN(b.x)], 1u);
            asm volatile("s_waitcnt vmcnt(0)" ::: "memory");
        } else {
            XB_SPIN(xb_ld(&bar[XB_XGEN(b.x)]) == gen, bar);
            __builtin_amdgcn_fence(__ATOMIC_ACQUIRE, "agent");
            asm volatile("s_waitcnt vmcnt(0)" ::: "memory");
        }
    }
    __syncthreads();
}

template <bool FULL>
__device__ __forceinline__ void hgrn_item(LAS unsigned char* lds, const bf16* U, bf16* Y, float* SEGS, float* SEGD, const float* normg, int item, int tid) {
    const int lane = tid & 63, w = __builtin_amdgcn_readfirstlane(tid >> 6), fr = lane & 15, fq = lane >> 4;
    const int j = item % NSEG, bh = item / NSEG, h = bh % NH, b = bh / NH;
    if (!FULL && j == NSEG - 1) return;
    const int row0 = b * SEQ + j * SEGL;
    LAS bf16* Qs = (LAS bf16*)(lds + Q_OFF); LAS bf16* KT = (LAS bf16*)(lds + KT_OFF); LAS bf16* KH = (LAS bf16*)(lds + KH_OFF); LAS bf16* VT = (LAS bf16*)(lds + VT_OFF);
    LAS bf16* ST = (LAS bf16*)(lds + ST_OFF); LAS bf16* PM = (LAS bf16*)(lds + PM_OFF); LAS float* OB = (LAS float*)(lds + OB_OFF);
    LAS float* TOT = (LAS float*)(lds + TOT_OFF); LAS float* DV = (LAS float*)(lds + DV_OFF); LAS float* DS = (LAS float*)(lds + DS_OFF);
    f32x4 S[8];
#pragma unroll
    for (int vt = 0; vt < 8; ++vt) S[vt] = (f32x4){0.f, 0.f, 0.f, 0.f};
    if (tid < 128) DS[tid] = 0.f;
    f32x4 n0 = (f32x4){0.f, 0.f, 0.f, 0.f}, n1 = n0, n2 = n0, n3 = n0;
    if constexpr (FULL) { const GAS float* ng = (const GAS float*)normg + h * HD + (tid & 7) * 16; n0 = *(const GAS f32x4*)ng; n1 = *(const GAS f32x4*)(ng + 4); n2 = *(const GAS f32x4*)(ng + 8); n3 = *(const GAS f32x4*)(ng + 12); }
    unsigned lf2[8], v2[8], q2[8];
#define HG_LOAD(cc) do { const GAS bf16* up_ = (const GAS bf16*)U + (size_t)(row0 + (cc) * 64 + 8 * w) * INW + h * HD + 2 * lane; _Pragma("unroll") for (int jj = 0; jj < 8; ++jj) { \
        lf2[jj] = *(const GAS unsigned*)(up_ + (size_t)jj * INW + 1024); v2[jj] = *(const GAS unsigned*)(up_ + (size_t)jj * INW + 1792); q2[jj] = FULL ? *(const GAS unsigned*)(up_ + (size_t)jj * INW + 256) : 0u; } } while (0)
    HG_LOAD(0);
    if (FULL) {
        f32x4 P = (f32x4){1.f, 1.f, 1.f, 1.f};
        for (int i = j - 1; i >= 0; --i) {
            const GAS float* Ki = (const GAS float*)SEGS + (size_t)(bh * NSEG + i) * 16384; const f32x4 dv = *(const GAS f32x4*)((const GAS float*)SEGD + (size_t)(bh * NSEG + i) * 128 + 16 * w + 4 * fq);
            f32x4 kv[8];
#pragma unroll
            for (int vt = 0; vt < 8; ++vt) kv[vt] = *(const GAS f32x4*)(Ki + (size_t)((vt * 8 + w) * 64 + lane) * 4);
#pragma unroll
            for (int vt = 0; vt < 8; ++vt) S[vt] = S[vt] + P * kv[vt];
            P = P * dv;
            if (__ballot((P[0] != 0.f) | (P[1] != 0.f) | (P[2] != 0.f) | (P[3] != 0.f)) == 0ull) break;
        }
#pragma unroll
        for (int vt = 0; vt < 8; ++vt) { u32x2 o; o.x = pk2(S[vt][0], S[vt][1]); o.y = pk2(S[vt][2], S[vt][3]); *(LAS u32x2*)(ST + (16 * vt + fr) * QP + 16 * w + 4 * fq) = o; }
    }
    __syncthreads();
    for (int c = 0; c < NCH; ++c) {
        const int r0 = row0 + c * 64;
        float f0[8], f1[8]; float a0 = 0.f, a1 = 0.f;
#pragma unroll
        for (int jj = 0; jj < 8; ++jj) { const float l0 = bflo(lf2[jj]), l1 = bfhi(lf2[jj]); a0 += l0; a1 += l1; f0[jj] = __expf(l0); f1[jj] = __expf(l1); }
        *(LAS f32x2*)(TOT + w * 128 + 2 * lane) = (f32x2){a0, a1};
        __syncthreads();
        float p0 = 0.f, p1 = 0.f, t0 = 0.f, t1 = 0.f;
#pragma unroll
        for (int g = 0; g < 8; ++g) { const f32x2 tv = *(const LAS f32x2*)(TOT + g * 128 + 2 * lane); if (g < w) { p0 += tv.x; p1 += tv.y; } t0 += tv.x; t1 += tv.y; }
        if (w == 0) { *(LAS f32x2*)(DV + 2 * lane) = (f32x2){__expf(t0), __expf(t1)}; const f32x2 ds = *(const LAS f32x2*)(DS + 2 * lane); *(LAS f32x2*)(DS + 2 * lane) = (f32x2){ds.x + t0, ds.y + t1}; }
        float kh0[8], kh1[8];
        {
          float gs0 = __expf(t0 - p0 - a0), gs1 = __expf(t1 - p1 - a1);
#pragma unroll
          for (int jj = 7; jj >= 0; --jj) { kh0[jj] = (1.0f - f0[jj]) * gs0; kh1[jj] = (1.0f - f1[jj]) * gs1; gs0 *= f0[jj]; gs1 *= f1[jj]; } }
        if (FULL) {
            float e0 = __expf(fmaxf(p0, -80.f)), e1 = __expf(fmaxf(p1, -80.f));
#pragma unroll
            for (int jj = 0; jj < 8; ++jj) {
                e0 = fmaxf(e0 * f0[jj], 1.8049e-35f); e1 = fmaxf(e1 * f1[jj], 1.8049e-35f);
                const float i0 = __builtin_amdgcn_rcpf(e0), i1 = __builtin_amdgcn_rcpf(e1);
                *(LAS unsigned*)(Qs + (8 * w + jj) * QP + 2 * lane) = pk2(bflo(q2[jj]) * e0, bfhi(q2[jj]) * e1);
                *(LAS unsigned*)(KT + (8 * w + jj) * QP + 2 * lane) = pk2((1.0f - f0[jj]) * i0, (1.0f - f1[jj]) * i1);
            }
        }
        { u32x4 o; o.x = pk2(kh0[0], kh0[1]); o.y = pk2(kh0[2], kh0[3]); o.z = pk2(kh0[4], kh0[5]); o.w = pk2(kh0[6], kh0[7]); *(LAS u32x4*)(KH + (2 * lane) * SP + 8 * w) = o;
          o.x = pk2(kh1[0], kh1[1]); o.y = pk2(kh1[2], kh1[3]); o.z = pk2(kh1[4], kh1[5]); o.w = pk2(kh1[6], kh1[7]); *(LAS u32x4*)(KH + (2 * lane + 1) * SP + 8 * w) = o;
          o.x = (v2[0] & 0xffffu) | (v2[1] << 16); o.y = (v2[2] & 0xffffu) | (v2[3] << 16); o.z = (v2[4] & 0xffffu) | (v2[5] << 16); o.w = (v2[6] & 0xffffu) | (v2[7] << 16); *(LAS u32x4*)(VT + (2 * lane) * SP + 8 * w) = o;
          o.x = (v2[0] >> 16) | (v2[1] & 0xffff0000u); o.y = (v2[2] >> 16) | (v2[3] & 0xffff0000u); o.z = (v2[4] >> 16) | (v2[5] & 0xffff0000u); o.w = (v2[6] >> 16) | (v2[7] & 0xffff0000u); *(LAS u32x4*)(VT + (2 * lane + 1) * SP + 8 * w) = o; }
        const int t_e = tid >> 3, vs_e = (tid & 7) * 16;
        u32x4 g0 = (u32x4){0u, 0u, 0u, 0u}, g1 = g0;
        if constexpr (FULL) { const GAS bf16* gp = (const GAS bf16*)U + (size_t)(r0 + t_e) * INW + 2560 + h * HD + vs_e; g0 = *(const GAS u32x4*)gp; g1 = *(const GAS u32x4*)(gp + 8); }
        if (c + 1 < NCH) HG_LOAD(c + 1);
        __syncthreads();
        const int tt = w >> 1;
        f32x4 oa[4];
        if constexpr (FULL) {
#pragma unroll
            for (int ti = 0; ti < 2; ++ti) { const int ts = (w & 1) * 2 + ti; f32x4 pa = (f32x4){0.f, 0.f, 0.f, 0.f};
                if (ts <= tt) {
#pragma unroll
                    for (int kk = 0; kk < 4; ++kk) { const bf16x8 a = *(const LAS bf16x8*)(KT + (ts * 16 + fr) * QP + kk * 32 + 8 * fq); const bf16x8 bq = *(const LAS bf16x8*)(Qs + (tt * 16 + fr) * QP + kk * 32 + 8 * fq); pa = MFMA16(a, bq, pa); }
                    if (ts == tt) {
#pragma unroll
                        for (int i = 0; i < 4; ++i) if (4 * fq + i > fr) pa[i] = 0.f;
                    }
                }
                u32x2 o; o.x = pk2(pa[0], pa[1]); o.y = pk2(pa[2], pa[3]); *(LAS u32x2*)(PM + (tt * 16 + fr) * SP + ts * 16 + 4 * fq) = o; }
            bf16x8 qf[4];
#pragma unroll
            for (int kk = 0; kk < 4; ++kk) qf[kk] = *(const LAS bf16x8*)(Qs + (tt * 16 + fr) * QP + kk * 32 + 8 * fq);
#pragma unroll
            for (int vi = 0; vi < 4; ++vi) { const int vt = (w & 1) * 4 + vi; oa[vi] = (f32x4){0.f, 0.f, 0.f, 0.f};
#pragma unroll
                for (int kk = 0; kk < 4; ++kk) { const bf16x8 sf = *(const LAS bf16x8*)(ST + (vt * 16 + fr) * QP + kk * 32 + 8 * fq); oa[vi] = MFMA16(sf, qf[kk], oa[vi]); } }
            __syncthreads();
            bf16x8 pf[2];
#pragma unroll
            for (int kk = 0; kk < 2; ++kk) pf[kk] = *(const LAS bf16x8*)(PM + (tt * 16 + fr) * SP + kk * 32 + 8 * fq);
#pragma unroll
            for (int vi = 0; vi < 4; ++vi) { const int vt = (w & 1) * 4 + vi;
#pragma unroll
                for (int kk = 0; kk < 2; ++kk) { const bf16x8 vf = *(const LAS bf16x8*)(VT + (vt * 16 + fr) * SP + kk * 32 + 8 * fq); oa[vi] = MFMA16(vf, pf[kk], oa[vi]); } }
        }
        { const f32x4 dv = *(const LAS f32x4*)(DV + 16 * w + 4 * fq); bf16x8 kf[2];
#pragma unroll
          for (int kk = 0; kk < 2; ++kk) kf[kk] = *(const LAS bf16x8*)(KH + (16 * w + fr) * SP + kk * 32 + 8 * fq);
#pragma unroll
          for (int vt = 0; vt < 8; ++vt) { S[vt] = S[vt] * dv;
#pragma unroll
              for (int kk = 0; kk < 2; ++kk) { const bf16x8 vf = *(const LAS bf16x8*)(VT + (vt * 16 + fr) * SP + kk * 32 + 8 * fq); S[vt] = MFMA16(kf[kk], vf, S[vt]); } } }
        if constexpr (FULL) {
#pragma unroll
            for (int vt = 0; vt < 8; ++vt) { u32x2 o; o.x = pk2(S[vt][0], S[vt][1]); o.y = pk2(S[vt][2], S[vt][3]); *(LAS u32x2*)(ST + (16 * vt + fr) * QP + 16 * w + 4 * fq) = o; }
#pragma unroll
            for (int vi = 0; vi < 4; ++vi) { const int vt = (w & 1) * 4 + vi; *(LAS f32x4*)(OB + (tt * 16 + fr) * OP + vt * 16 + 4 * fq) = oa[vi]; }
            __syncthreads();
            const int t = t_e, vs = vs_e;
            f32x4 o4[4]; float ssq = 0.f;
#pragma unroll
            for (int q = 0; q < 4; ++q) { o4[q] = *(const LAS f32x4*)(OB + t * OP + vs + 4 * q); ssq += (o4[q][0] * o4[q][0] + o4[q][1] * o4[q][1]) + (o4[q][2] * o4[q][2] + o4[q][3] * o4[q][3]); }
            ssq += __shfl_xor(ssq, 1); ssq += __shfl_xor(ssq, 2); ssq += __shfl_xor(ssq, 4);
            const float rs = rsqrtf(ssq * (1.0f / 128.0f) + EPS);
            u32x4 y0, y1;
            y0.x = pk2(o4[0][0] * rs * n0[0] * bflo(g0.x), o4[0][1] * rs * n0[1] * bfhi(g0.x)); y0.y = pk2(o4[0][2] * rs * n0[2] * bflo(g0.y), o4[0][3] * rs * n0[3] * bfhi(g0.y));
            y0.z = pk2(o4[1][0] * rs * n1[0] * bflo(g0.z), o4[1][1] * rs * n1[1] * bfhi(g0.z)); y0.w = pk2(o4[1][2] * rs * n1[2] * bflo(g0.w), o4[1][3] * rs * n1[3] * bfhi(g0.w));
            y1.x = pk2(o4[2][0] * rs * n2[0] * bflo(g1.x), o4[2][1] * rs * n2[1] * bfhi(g1.x)); y1.y = pk2(o4[2][2] * rs * n2[2] * bflo(g1.y), o4[2][3] * rs * n2[3] * bfhi(g1.y));
            y1.z = pk2(o4[3][0] * rs * n3[0] * bflo(g1.z), o4[3][1] * rs * n3[1] * bfhi(g1.z)); y1.w = pk2(o4[3][2] * rs * n3[2] * bflo(g1.w), o4[3][3] * rs * n3[3] * bfhi(g1.w));
            GAS bf16* yp = (GAS bf16*)Y + (size_t)(r0 + t) * D + PW + h * HD + vs;
            *(GAS u32x4*)yp = y0; *(GAS u32x4*)(yp + 8) = y1;
        }
    }
    if (!FULL) {
        { const __amdgpu_buffer_rsrc_t srsrc = __builtin_amdgcn_make_buffer_rsrc((void*)SEGS, 0, NHITEMS * 65536, 0x00020000);
#pragma unroll
          for (int vt = 0; vt < 8; ++vt) __builtin_amdgcn_raw_buffer_store_b128(__builtin_bit_cast(u32x4, S[vt]), srsrc, (unsigned)(((size_t)item * 16384 + (size_t)((vt * 8 + w) * 64 + lane) * 4) * 4), 0, 16); }
        if (tid < 128) __hip_atomic_store((GAS float*)SEGD + (size_t)item * 128 + tid, __expf(DS[tid]), __ATOMIC_RELAXED, __HIP_MEMORY_SCOPE_AGENT);
    }
    __syncthreads();
#undef HG_LOAD
}

constexpr int XT_OFF = 0, PPQ_OFF = 41728, WTQ_OFF = 75520, SCL_OFF = 112384;
static_assert(79 * PPP * 2 <= PPQ_OFF && PPQ_OFF + 64 * PPP * 2 <= WTQ_OFF && WTQ_OFF + 256 * SP * 2 <= SCL_OFF && SCL_OFF + 1024 <= 131072, "pool LDS map");
template <int WIN>
__device__ __forceinline__ void pool_win(const LAS bf16* XT, LAS bf16* PP, int run, int tseq0, int g, int pair) {
    const LAS bf16* xp = XT + (run * 16 + 15 - (WIN - 1)) * PPP + g * 64 + 2 * pair;
    unsigned xv[16 + WIN - 1];
#pragma unroll
    for (int i = 0; i < 16 + WIN - 1; ++i) xv[i] = *(const LAS unsigned*)(xp + i * PPP);
    float s0 = 0.f, s1 = 0.f;
#pragma unroll
    for (int i = 0; i < WIN - 1; ++i) { s0 += bflo(xv[i]); s1 += bfhi(xv[i]); }
    LAS bf16* pp = PP + (run * 16) * PPP + g * 64 + 2 * pair;
#pragma unroll
    for (int jj = 0; jj < 16; ++jj) { const float x0 = bflo(xv[jj + WIN - 1]), x1 = bfhi(xv[jj + WIN - 1]); s0 += x0; s1 += x1;
        const int cn = tseq0 + jj + 1; const float ic = 1.0f / (float)(cn < WIN ? cn : WIN);
        *(LAS unsigned*)(pp + jj * PPP) = pk2(s0 * ic - x0, s1 * ic - x1);
        s0 -= bflo(xv[jj]); s1 -= bfhi(xv[jj]); }
}
__device__ __forceinline__ void pool_item(LAS unsigned char* lds, const bf16* U, bf16* Y, const float* poolw, const float* pscale, int item, int tid) {
    const int lane = tid & 63, w = __builtin_amdgcn_readfirstlane(tid >> 6), fr = lane & 15, fq = lane >> 4;
    LAS bf16* XT = (LAS bf16*)(lds + XT_OFF); LAS bf16* PP = (LAS bf16*)(lds + PPQ_OFF); LAS bf16* WT = (LAS bf16*)(lds + WTQ_OFF);
    LAS float* SCL = (LAS float*)(lds + SCL_OFF); if (tid < PW) SCL[tid] = ((const GAS float*)pscale)[tid];
    const int Rb = item * 256, bstart = (Rb / SEQ) * SEQ;
    u32x4 xr[5];
#define PL_LOAD(qq) do { _Pragma("unroll") for (int i = 0; i < 5; ++i) { const int ch = tid + 512 * i, row = ch >> 5, cc = ch & 31, tg = Rb + (qq) * 64 - 15 + row; \
        xr[i] = (ch < 79 * 32 && tg >= bstart) ? *(const GAS u32x4*)((const GAS bf16*)U + (size_t)tg * INW + cc * 8) : (u32x4){0u, 0u, 0u, 0u}; } } while (0)
    PL_LOAD(0);
    { const int wbase = (tid & 63) * SP + (tid >> 6);
#pragma unroll
      for (int i = 0; i < 32; ++i) WT[wbase + (i >> 3) * 64 * SP + 8 * (i & 7)] = (bf16)(pk2(((const GAS float*)poolw)[tid + 512 * i], 0.f) & 0xffffu); }
#pragma unroll 1
    for (int qq = 0; qq < 4; ++qq) {
#pragma unroll
        for (int i = 0; i < 5; ++i) { const int ch = tid + 512 * i, row = ch >> 5, cc = ch & 31; if (ch < 79 * 32) *(LAS u32x4*)(XT + row * PPP + cc * 8) = xr[i]; }
        if (qq + 1 < 4) PL_LOAD(qq + 1);
        __syncthreads();
        { const int g = w & 3, pair = lane & 31, run = (w >> 2) * 2 + (lane >> 5), tseq0 = (Rb + qq * 64 + run * 16) % SEQ;
          if (g == 0) pool_win<2>(XT, PP, run, tseq0, 0, pair); else if (g == 1) pool_win<4>(XT, PP, run, tseq0, 1, pair); else if (g == 2) pool_win<8>(XT, PP, run, tseq0, 2, pair); else pool_win<16>(XT, PP, run, tseq0, 3, pair); }
        __syncthreads();
        { const int tt = w & 3, gh = w >> 2;
#pragma unroll
          for (int gi = 0; gi < 2; ++gi) { const int g = 2 * gh + gi; bf16x8 pf[2];
#pragma unroll
            for (int kk = 0; kk < 2; ++kk) pf[kk] = *(const LAS bf16x8*)(PP + (16 * tt + fr) * PPP + g * 64 + kk * 32 + 8 * fq);
#pragma unroll
            for (int dt = 0; dt < 4; ++dt) { f32x4 acc = (f32x4){0.f, 0.f, 0.f, 0.f};
#pragma unroll
                for (int kk = 0; kk < 2; ++kk) { const bf16x8 wf = *(const LAS bf16x8*)(WT + (g * 64 + dt * 16 + fr) * SP + kk * 32 + 8 * fq); acc = MFMA16(wf, pf[kk], acc); }
                const int dcol = g * 64 + dt * 16 + 4 * fq; const f32x4 sc = *(const LAS f32x4*)(SCL + dcol);
                u32x2 o; o.x = pk2(acc[0] * sc[0], acc[1] * sc[1]); o.y = pk2(acc[2] * sc[2], acc[3] * sc[3]);
                *(GAS u32x2*)((GAS bf16*)Y + (size_t)(Rb + qq * 64 + 16 * tt + fr) * D + dcol) = o; } } }
        __syncthreads();
    }
#undef PL_LOAD
}

struct Args { const float* in[12]; float* out; unsigned char* ws; int ph_lo, ph_hi; };
static_assert(sizeof(Args) == 12 * 8 + 8 + 8 + 8, "Args has no padding");

__global__ void __launch_bounds__(NWAVES * 64, 2) mk_fwd(Args args) {
    extern __shared__ __attribute__((aligned(16))) unsigned char lds_raw[];
    LAS unsigned char* lds = (LAS unsigned char*)lds_raw;
    const int tid = threadIdx.x, lane = tid & 63, wave = __builtin_amdgcn_readfirstlane(tid >> 6);
    const int G = gridDim.x, bx = blockIdx.x, gw = bx * NWAVES + wave, ngw = G * NWAVES;
    unsigned char* ws = args.ws;
    float* X = args.out;
#define INPTRS(A) const float* norm_mix_g = (A).in[1]; const float* w_in = (A).in[2]; const float* pool_w = (A).in[3]; const float* pool_scale = (A).in[4]; \
    const float* hgrn_norm_g = (A).in[6]; const float* w_out = (A).in[7]; const float* norm_mlp_g = (A).in[8]; const float* w_up = (A).in[9]; const float* w_down = (A).in[10];
#define WSPTRS(wsb) bf16* WIN = (bf16*)((wsb) + WS_WIN); bf16* WIN2 = (bf16*)((wsb) + WS_WIN2); bf16* WOUT = (bf16*)((wsb) + WS_WOUT); bf16* WUP = (bf16*)((wsb) + WS_WUP); bf16* WDN = (bf16*)((wsb) + WS_WDN); \
    bf16* XB = (bf16*)((wsb) + WS_XB); bf16* Yb = (bf16*)((wsb) + WS_Y); bf16* U = (bf16*)((wsb) + WS_U); bf16* Hb = (bf16*)((wsb) + WS_U); \
    float* SEGS = (float*)((wsb) + WS_SEGS); float* SEGD = (float*)((wsb) + WS_SEGD); float* SS = (float*)((wsb) + WS_SS); float* LB = (float*)((wsb) + WS_LB);
    const int lo = args.ph_lo, hi = args.ph_hi;
#if MK_SINGLE
    volatile LAS unsigned* MISC = (volatile LAS unsigned*)(lds + MISC_OFF);
    if (tid < 32) MISC[tid] = 0u;
    __syncthreads();
    (void)xcd_barrier_post((unsigned*)(ws + WS_BAR), MISC);
#define SEAM(k) do { if ((k) + 1 < hi) { { XcdBarrier xb_; xb_.bar = (unsigned*)(args.ws + WS_BAR); xb_.x = xb_xcc_id(); xb_.st = (volatile LAS unsigned*)(lds + MISC_OFF); xcd_barrier(xb_); } } } while (0)
#else
#define SEAM(k) do { } while (0)
#endif
#define IN(k) (lo <= (k) && (k) < hi)

    if (IN(0)) {
        WSPTRS(ws)
        const float* x_in = args.in[0]; const float* norm_mix_g = args.in[1]; const float* w_in = args.in[2]; const float* lb_logits = args.in[5];
        if (bx == 0) for (int ch = tid; ch < HW; ch += NWAVES * 64) {
            float l0 = lb_logits[ch], l1 = lb_logits[HW + ch], l2 = lb_logits[2 * HW + ch], l3 = lb_logits[3 * HW + ch];
            const float mx = fmaxf(fmaxf(l0, l1), fmaxf(l2, l3)); l0 = expf(l0 - mx); l1 = expf(l1 - mx); l2 = expf(l2 - mx); l3 = expf(l3 - mx);
            const float inv = 1.0f / (l0 + l1 + l2 + l3);
            LB[ch] = 0.f; LB[HW + ch] = l1 * inv; LB[2 * HW + ch] = (l1 + l2) * inv; LB[3 * HW + ch] = (l1 + l2 + l3) * inv; }
        (void)convert_one(lds, w_in, norm_mix_g, WIN, D, INW, 0, gw, ngw, wave, lane);
        for (int m = gw; m < M; m += 2 * ngw) {
            const int m2 = m + ngw; const bool has2 = m2 < M;
            const f32x4* xr = (const f32x4*)(x_in + (size_t)m * D) + lane; const f32x4* xr2 = (const f32x4*)(x_in + (size_t)(has2 ? m2 : m) * D) + lane; f32x4 v[4], v2[4]; float s = 0.f, s2 = 0.f;
#pragma unroll
            for (int j = 0; j < 4; ++j) { v[j] = xr[64 * j]; v2[j] = xr2[64 * j]; }
#pragma unroll
            for (int j = 0; j < 4; ++j) { s += (v[j][0] * v[j][0] + v[j][1] * v[j][1]) + (v[j][2] * v[j][2] + v[j][3] * v[j][3]); s2 += (v2[j][0] * v2[j][0] + v2[j][1] * v2[j][1]) + (v2[j][2] * v2[j][2] + v2[j][3] * v2[j][3]); }
            s = wave_sum(s); s2 = wave_sum(s2);
            u32x2* bo = (u32x2*)(XB + (size_t)m * D) + lane; u32x2* bo2 = (u32x2*)(XB + (size_t)m2 * D) + lane;
#pragma unroll
            for (int j = 0; j < 4; ++j) { u32x2 o; o.x = pk2(v[j][0], v[j][1]); o.y = pk2(v[j][2], v[j][3]); bo[64 * j] = o; if (has2) { u32x2 o2; o2.x = pk2(v2[j][0], v2[j][1]); o2.y = pk2(v2[j][2], v2[j][3]); bo2[64 * j] = o2; } }
            if (lane < 16) { SS[(size_t)m * 16 + lane] = (lane == 0) ? s : 0.f; if (has2) SS[(size_t)m2 * 16 + lane] = (lane == 0) ? s2 : 0.f; }
        }
        SEAM(0);
    }
#pragma unroll 1
    for (int l = 0; l < DEPTH; ++l) {
        const int pb = 1 + 5 * l;
        int tid_l = threadIdx.x; asm volatile("" : "+v"(tid_l));
        unsigned char* ws_l = ws; asm volatile("" : "+s"(ws_l));
        const int lane_l = tid_l & 63, wave_l = __builtin_amdgcn_readfirstlane(tid_l >> 6), gw_l = bx * NWAVES + wave_l;
        WSPTRS(ws_l)
        const __attribute__((address_space(4))) Args* ap = (const __attribute__((address_space(4))) Args*)__builtin_amdgcn_kernarg_segment_ptr(); asm volatile("" : "+s"(ap));
        INPTRS(*ap)
        float* X = ap->out;
#pragma unroll 1
        for (int sub = 0; sub < 2; ++sub) {
            if (IN(pb + sub)) {
                int tid_s = threadIdx.x; asm volatile("" : "+v"(tid_s));
                const int lane_s = tid_s & 63, wave_s = __builtin_amdgcn_readfirstlane(tid_s >> 6);
                bf16* WINc = (l & 1) ? WIN2 : WIN;
                const bool pool_cu = bx >= NHITEMS && bx < NHITEMS + NPOOL;
                unsigned* pf = (unsigned*)(ws_l + WS_BAR + WS_PFLAG); const unsigned ep = (unsigned)(l + 1);
                if (sub == 1 && bx < NHITEMS) {
                    hgrn_item<false>(lds, U, Yb, SEGS, SEGD, hgrn_norm_g + l * HW, bx, tid_s);
                    asm volatile("s_waitcnt vmcnt(0)" ::: "memory");
                    __syncthreads();
                    if (tid_s == 0) __hip_atomic_store(pf + 64 * (64 + bx), ep, __ATOMIC_RELAXED, __HIP_MEMORY_SCOPE_AGENT);
                    { const int cgw = bx * NWAVES + wave_s, cngw = NHITEMS * NWAVES;
                      int cb = convert_one(lds, w_out + (size_t)l * D * D, nullptr, WOUT, D, D, 0, cgw, cngw, wave_s, lane_s);
                      cb = convert_one(lds, w_up + (size_t)l * D * FF, norm_mlp_g + l * D, WUP, D, FF, cb, cgw, cngw, wave_s, lane_s);
                      cb = convert_one(lds, w_down + (size_t)l * FF * D, nullptr, WDN, FF, D, cb, cgw, cngw, wave_s, lane_s); }
                    if (tid_s < 64) { const int jseg = bx % NSEG, f0i = 64 + (bx / NSEG) * NSEG; const bool mine = lane_s < jseg; unsigned sp = 0;
                        for (;;) { const bool ok = !mine || __hip_atomic_load(pf + 64 * (f0i + lane_s), __ATOMIC_RELAXED, __HIP_MEMORY_SCOPE_AGENT) == ep;
                                   if (__ballot(!ok) == 0ull) break; __builtin_amdgcn_s_sleep(2); if (++sp > (1u << 20)) break; } }
                    if (tid_s == 0) { __builtin_amdgcn_fence(__ATOMIC_ACQUIRE, "agent"); asm volatile("s_waitcnt vmcnt(0)" ::: "memory"); }
                    __syncthreads();
                    hgrn_item<true>(lds, U, Yb, SEGS, SEGD, hgrn_norm_g + l * HW, bx, tid_s);
                }
                if (sub == 0 || (sub == 1 && pool_cu)) {
                    pg8::Gemm g{XB, WINc, M, INW, D}; pg8::FlexOrder S; S.base.init(M, INW - PW, G, bx); S.pn0 = 1; S.single = sub; S.pm1 = bx - NHITEMS; S.pn1 = 0;
                    pg8::EpiAct E{U, INW, SS + (size_t)(2 * l) * M * 16, LB + l * HW, 1};
                    pg8::gemm_phase<pg8::EpiAct, pg8::FlexOrder, true, true>(lds, g, S, E);
                }
                if (sub == 1 && pool_cu) {
                    const int p = bx - NHITEMS;
                    asm volatile("s_waitcnt vmcnt(0)" ::: "memory");
                    __syncthreads();
                    if (tid_s == 0) __hip_atomic_store(pf + 64 * p, ep, __ATOMIC_RELAXED, __HIP_MEMORY_SCOPE_AGENT);
                    if ((p % (SEQ / 256)) != 0 && tid_s < 64) {
                        unsigned sp = 0; while (__hip_atomic_load(pf + 64 * (p - 1), __ATOMIC_RELAXED, __HIP_MEMORY_SCOPE_AGENT) != ep) { __builtin_amdgcn_s_sleep(2); if (++sp > (1u << 20)) break; } }
                    if (tid_s == 0) { __builtin_amdgcn_fence(__ATOMIC_ACQUIRE, "agent"); asm volatile("s_waitcnt vmcnt(0)" ::: "memory"); }
                    __syncthreads();
                    pool_item(lds, U, Yb, pool_w + (size_t)l * 16384, pool_scale + l * PW, p, tid_s);
                }
                SEAM(pb + sub);
            }
        }
        if (IN(pb + 2) ) {
            pg8::Gemm g{Yb, WOUT, M, D, D}; pg8::StaticOrder S; S.init(M, D, G, bx);
            pg8::EpiResid E{XB, SS + (size_t)(2 * l + 1) * M * 16};
            pg8::gemm_phase<pg8::EpiResid, pg8::StaticOrder, true, true>(lds, g, S, E);
            SEAM(pb + 2) ;
        }
        if (IN(pb + 3) ) {
            if ((bx & 8) && l + 1 < DEPTH) {
                int tid_c = threadIdx.x; asm volatile("" : "+v"(tid_c));
                const int lane_c = tid_c & 63, wave_c = __builtin_amdgcn_readfirstlane(tid_c >> 6);
                (void)convert_one(lds, w_in + (size_t)(l + 1) * D * INW, norm_mix_g + (l + 1) * D, ((l + 1) & 1) ? WIN2 : WIN, D, INW, 0, ((bx >> 4) * 8 + (bx & 7)) * NWAVES + wave_c, (G / 2) * NWAVES, wave_c, lane_c);
                __syncthreads();
            }
            pg8::Gemm g{XB, WUP, M, FF, D}; pg8::StaticOrder S; S.init(M, FF, G, bx);
            pg8::EpiAct E{Hb, FF, SS + (size_t)(2 * l + 1) * M * 16, nullptr, 0};
            pg8::gemm_phase<pg8::EpiAct, pg8::StaticOrder, true, true>(lds, g, S, E);
            SEAM(pb + 3) ;
        }
        if (IN(pb + 4) ) {
            pg8::Gemm g{Hb, WDN, M, D, FF}; pg8::StaticOrder S; S.init(M, D, G, bx);
            pg8::EpiResid E{XB, SS + (size_t)(2 * l + 2) * M * 16};
            pg8::gemm_phase<pg8::EpiResid, pg8::StaticOrder, true, true>(lds, g, S, E);
            SEAM(pb + 4) ;
        }
    }
    if (IN(NPHASES - 1)) {
        int tid_f = threadIdx.x; asm volatile("" : "+v"(tid_f));
        const int lane_f = tid_f & 63, gw_f = bx * NWAVES + __builtin_amdgcn_readfirstlane(tid_f >> 6);
        const float* ssf = (const float*)(args.ws + WS_SS) + (size_t)(2 * DEPTH) * M * 16; float* Xf = args.out;
        for (int m = gw_f; m < M; m += 2 * ngw) {
            const int m2 = m + ngw; const bool has2 = m2 < M; const int mb = has2 ? m2 : m;
            const float q1 = lane_f < 16 ? ssf[(size_t)m * 16 + lane_f] : 0.f, q2 = lane_f < 16 ? ssf[(size_t)mb * 16 + lane_f] : 0.f;
            const u32x2* br = (const u32x2*)((const bf16*)(args.ws + WS_XB) + (size_t)m * D) + lane_f; const u32x2* br2 = (const u32x2*)((const bf16*)(args.ws + WS_XB) + (size_t)mb * D) + lane_f;
            u32x2 b1[4], b2[4];
#pragma unroll
            for (int j = 0; j < 4; ++j) { b1[j] = br[64 * j]; b2[j] = br2[64 * j]; }
            const float rs = rsqrtf(wave_sum(q1) * (1.0f / D) + EPS), rs2 = rsqrtf(wave_sum(q2) * (1.0f / D) + EPS);
            f32x4* xr = (f32x4*)(Xf + (size_t)m * D) + lane_f; f32x4* xr2 = (f32x4*)(Xf + (size_t)mb * D) + lane_f; const f32x4* gr = (const f32x4*)args.in[11] + lane_f;
#pragma unroll
            for (int j = 0; j < 4; ++j) { const f32x4 gv = gr[64 * j]; const f32x4 xv = (f32x4){bflo(b1[j].x), bfhi(b1[j].x), bflo(b1[j].y), bfhi(b1[j].y)}; xr[64 * j] = xv * rs * gv;
                if (has2) { const f32x4 xw = (f32x4){bflo(b2[j].x), bfhi(b2[j].x), bflo(b2[j].y), bfhi(b2[j].y)}; xr2[64 * j] = xw * rs2 * gv; } }
        }
    }
#undef IN
#undef SEAM
}

extern "C" void kernel_launch(void* const* d_in, const int* in_sizes, int n_in, void* d_out, int out_size, void* d_ws, size_t ws_size, hipStream_t stream) {
    static int grid = 0;
    if (grid == 0) {
        if (n_in != 12 || in_sizes[0] != M * D || out_size != M * D || ws_size < WS_END) { fprintf(stderr, "kernel_launch: unexpected shapes (n_in %d, in0 %d, out %d, ws %zu)\n", n_in, n_in > 0 ? in_sizes[0] : -1, out_size, ws_size); grid = -1; return; }
        int dev = 0, cus = 0, per_cu = 0;
        if (hipGetDevice(&dev) != hipSuccess || hipDeviceGetAttribute(&cus, hipDeviceAttributeMultiprocessorCount, dev) != hipSuccess) { grid = -1; return; }
        if (hipFuncSetAttribute((const void*)mk_fwd, hipFuncAttributeMaxDynamicSharedMemorySize, LDS_BYTES) != hipSuccess) { fprintf(stderr, "kernel_launch: hipFuncSetAttribute failed\n"); grid = -1; return; }
        if (hipOccupancyMaxActiveBlocksPerMultiprocessor(&per_cu, (const void*)mk_fwd, NWAVES * 64, LDS_BYTES) != hipSuccess || per_cu < 1) { fprintf(stderr, "kernel_launch: occupancy query says %d\n", per_cu); per_cu = 1; }
        (void)hipGetLastError();
        grid = cus * (per_cu < 1 ? 1 : per_cu);
        if (grid > 256) grid = 256;
        if (grid < NHITEMS + NPOOL) { fprintf(stderr, "kernel_launch: needs %d co-resident workgroups, have %d\n", NHITEMS + NPOOL, grid); grid = -1; return; }
    }
    if (grid < 0) return;
    (void)hipMemsetAsync((char*)d_ws + WS_BAR, 0, BAR_ZERO_BYTES, stream);
    Args a{};
    for (int i = 0; i < 12; ++i) a.in[i] = (const float*)d_in[i];
    a.out = (float*)d_out; a.ws = (unsigned char*)d_ws;
#if MK_SINGLE
    a.ph_lo = 0; a.ph_hi = NPHASES;
    void* kargs[] = {&a};
    hipError_t e = hipLaunchCooperativeKernel((const void*)mk_fwd, dim3(grid), dim3(NWAVES * 64), kargs, LDS_BYTES, stream);
    if (e != hipSuccess) fprintf(stderr, "kernel_launch: cooperative launch failed: %s (grid %d)\n", hipGetErrorString(e), grid);
#else
    for (int p = 0; p < NPHASES; ++p) { a.ph_lo = p; a.ph_hi = p + 1; hipLaunchKernelGGL(mk_fwd, dim3(grid), dim3(NWAVES * 64), LDS_BYTES, stream, a); }
#endif
}
```

```cpp
#include <hip/hip_runtime.h>
#include <hip/hip_cooperative_groups.h>
#include <cstdio>
#include <cstdint>
namespace cg = cooperative_groups;
namespace pg8 {
#define PG8_LAS __attribute__((address_space(3)))
typedef unsigned short bf16_t;
typedef short bf16x8 __attribute__((ext_vector_type(8)));
typedef float f32x4 __attribute__((ext_vector_type(4)));
typedef unsigned u32x4 __attribute__((ext_vector_type(4)));
constexpr int BM = 256, BK = 64, HALF = 128, HTB = HALF * BK * 2  , STAGE_BYTES = 8 * HTB, NXCD = 8, WGM = 8;

__host__ __device__ __forceinline__ int lds_byte(int r, int c) { const int st = (r >> 4) * 2 + (c >> 5), rr = r & 15, cc = c & 31, ob = rr * 64 + cc * 2; return st * 1024 + (ob ^ (((ob >> 9) & 1) << 5)); }
__host__ __device__ __forceinline__ void stage_rc(int b, int& R, int& C) { const int st = b / 1024, sb = b % 1024, swz = sb ^ (((sb >> 9) & 1) << 5); R = (st >> 1) * 16 + swz / 64; C = (st & 1) * 32 + (swz % 64) / 2; }
__host__ __device__ __forceinline__ int perm32(int rho) { const int n = rho >> 4, i = rho & 15; return 8 * (i >> 2) + 4 * n + (i & 3); }

struct Unit { int pm, pn; };
struct Gemm { const bf16_t* A; const bf16_t* Bt; int M, N, K; };

struct StaticOrder {
    int nM, nN, nwg, G, c;
    __host__ __device__ void init(int M, int N, int G_, int c_) { nM = M / BM; nN = N / BM; nwg = nM * nN; G = G_; c = c_; }
    __host__ __device__ bool next(int i, Unit& u) const {
        const long L = (long)i * G + c; if (L >= nwg) return false;
        int wgid = (int)L; { const int q = nwg / NXCD, r = nwg % NXCD, xcd = wgid % NXCD, off = wgid / NXCD; wgid = (xcd < r ? xcd * (q + 1) : r * (q + 1) + (xcd - r) * q) + off; }
        const int nig = WGM * nN, gid = wgid / nig, fm = gid * WGM, gsz = (nM - fm) < WGM ? (nM - fm) : WGM;
        u.pm = fm + ((wgid % nig) % gsz); u.pn = (wgid % nig) / gsz; return true;
    }
    __device__ __forceinline__ void a_ready(const Unit&) const {}
    __device__ __forceinline__ void done(const Unit&) const {}
};

struct OffsetOrder {
    StaticOrder base; int pn0;
    __device__ __forceinline__ bool next(int i, Unit& u) const { if (!base.next(i, u)) return false; u.pn += pn0; return true; }
    __device__ __forceinline__ void a_ready(const Unit&) const {}
    __device__ __forceinline__ void done(const Unit&) const {}
};
struct FlexOrder {
    StaticOrder base; int pn0, single, pm1, pn1;
    __device__ __forceinline__ bool next(int i, Unit& u) const { if (single) { if (i > 0) return false; u.pm = pm1; u.pn = pn1; return true; } if (!base.next(i, u)) return false; u.pn += pn0; return true; }
    __device__ __forceinline__ void a_ready(const Unit&) const {}
    __device__ __forceinline__ void done(const Unit&) const {}
};
struct SingleUnit {
    int pm, pn;
    __device__ __forceinline__ bool next(int i, Unit& u) const { if (i > 0) return false; u.pm = pm; u.pn = pn; return true; }
    __device__ __forceinline__ void a_ready(const Unit&) const {}
    __device__ __forceinline__ void done(const Unit&) const {}
};
__device__ __forceinline__ unsigned cvt_pk_bf16(float lo, float hi) { unsigned r; asm volatile("v_cvt_pk_bf16_f32 %0, %1, %2" : "=v"(r) : "v"(lo), "v"(hi)); return r; }
typedef float f32x2 __attribute__((ext_vector_type(2)));

typedef unsigned u32x2 __attribute__((ext_vector_type(2)));
__device__ __forceinline__ float fast_rcp(float x) { return __builtin_amdgcn_rcpf(x); }
__device__ __forceinline__ float silu_f(float v) { return v * fast_rcp(1.0f + __expf(-v)); }
struct EpiAct {
    static constexpr bool PERM = true, AFTER_DRAIN = false;
    bf16_t* O; int ldc; const float* ss; const float* lb; int is_in;
    __device__ __forceinline__ void operator()(const f32x4 (&acc)[2][2][4][2], const Unit& u, int wr, int wc, int fr, int fq) const {
        const int row0 = u.pm * BM + wr * 64 + fr; const int col0 = u.pn * BM + wc * 32 + 8 * fq;
        const __amdgpu_buffer_rsrc_t orsrc = __builtin_amdgcn_make_buffer_rsrc((void*)O, 0, 0x7ffffff0, 0x00020000);
        int mode = 3;
        if (is_in) { const int t = u.pn; mode = (t == 0) ? 0 : (t <= 3 ? 1 : (t <= 6 ? 2 : (t <= 9 ? 0 : 1))); }
        float rsv[2][4];
        { f32x4 pv[2][4];
#pragma unroll
          for (int ai = 0; ai < 2; ++ai)
#pragma unroll
              for (int m = 0; m < 4; ++m) pv[ai][m] = *(const f32x4*)(ss + (size_t)(row0 + ai * HALF + m * 16) * 16 + 4 * fq);
          f32x4 lbv[2][2];
#pragma unroll
          for (int bj = 0; bj < 2; ++bj)
#pragma unroll
              for (int n = 0; n < 2; ++n) lbv[bj][n] = (mode == 2) ? *(const f32x4*)(lb + (col0 - 1024) + bj * HALF + 4 * n) : (f32x4){0.f, 0.f, 0.f, 0.f};
#pragma unroll
          for (int ai = 0; ai < 2; ++ai)
#pragma unroll
              for (int m = 0; m < 4; ++m) { float t = (pv[ai][m][0] + pv[ai][m][1]) + (pv[ai][m][2] + pv[ai][m][3]); t += __shfl_xor(t, 16); t += __shfl_xor(t, 32); rsv[ai][m] = rsqrtf(t * (1.0f / 1024.0f) + 1e-5f); }
#pragma unroll
        for (int ai = 0; ai < 2; ++ai)
#pragma unroll
            for (int m = 0; m < 4; ++m) { const int r = row0 + ai * HALF + m * 16; const float rs = rsv[ai][m];
                bf16_t* rowp = O + (size_t)r * ldc + col0;
#pragma unroll
                for (int bj = 0; bj < 2; ++bj) { f32x4 v[2]; v[0] = acc[ai][bj][m][0] * rs; v[1] = acc[ai][bj][m][1] * rs;
                    if (mode == 1) {
#pragma unroll
                        for (int n = 0; n < 2; ++n)
#pragma unroll
                            for (int e = 0; e < 4; ++e) v[n][e] = silu_f(v[n][e]);
                    } else if (mode == 2) {
#pragma unroll
                        for (int n = 0; n < 2; ++n)
#pragma unroll
                            for (int e = 0; e < 4; ++e) { const float s = fast_rcp(1.0f + __expf(-v[n][e])); const float l = lbv[bj][n][e]; v[n][e] = __logf(l + (1.0f - l) * s); }
                    } else if (mode == 3) {
#pragma unroll
                        for (int n = 0; n < 2; ++n)
#pragma unroll
                            for (int e = 0; e < 4; ++e) { const float t = fmaxf(v[n][e], 0.f); v[n][e] = t * t; }
                    }
                    u32x4 w; w.x = cvt_pk_bf16(v[0][0], v[0][1]); w.y = cvt_pk_bf16(v[0][2], v[0][3]); w.z = cvt_pk_bf16(v[1][0], v[1][1]); w.w = cvt_pk_bf16(v[1][2], v[1][3]);
                    __builtin_amdgcn_raw_buffer_store_b128(w, orsrc, (unsigned)(((size_t)r * ldc + col0 + bj * HALF) * 2), 0, 16); } }
        }
    }
};
struct EpiResid {
    static constexpr bool PERM = true, AFTER_DRAIN = false;
    bf16_t* XB; float* ss;
    __device__ __forceinline__ void operator()(const f32x4 (&acc)[2][2][4][2], const Unit& u, int wr, int wc, int fr, int fq) const {
        const int col0 = u.pn * BM + wc * 32 + 8 * fq;
        u32x4 xo[2][4][2];
#pragma unroll
        for (int ai = 0; ai < 2; ++ai)
#pragma unroll
            for (int m = 0; m < 4; ++m)
#pragma unroll
                for (int bj = 0; bj < 2; ++bj) xo[ai][m][bj] = *(const u32x4*)(XB + (size_t)(u.pm * BM + ai * HALF + wr * 64 + m * 16 + fr) * 1024 + col0 + bj * HALF);
#pragma unroll
        for (int ai = 0; ai < 2; ++ai)
#pragma unroll
            for (int m = 0; m < 4; ++m) { const int r = u.pm * BM + ai * HALF + wr * 64 + m * 16 + fr; const size_t off = (size_t)r * 1024 + col0; float sq = 0.f;
#pragma unroll
                for (int bj = 0; bj < 2; ++bj) { const u32x4 x = xo[ai][m][bj]; const f32x4 a = acc[ai][bj][m][0], b = acc[ai][bj][m][1];
                    const float o0 = __uint_as_float(x.x << 16) + a[0], o1 = __uint_as_float(x.x & 0xffff0000u) + a[1], o2 = __uint_as_float(x.y << 16) + a[2], o3 = __uint_as_float(x.y & 0xffff0000u) + a[3];
                    const float o4 = __uint_as_float(x.z << 16) + b[0], o5 = __uint_as_float(x.z & 0xffff0000u) + b[1], o6 = __uint_as_float(x.w << 16) + b[2], o7 = __uint_as_float(x.w & 0xffff0000u) + b[3];
                    sq += ((o0 * o0 + o1 * o1) + (o2 * o2 + o3 * o3)) + ((o4 * o4 + o5 * o5) + (o6 * o6 + o7 * o7));
                    u32x4 w; w.x = cvt_pk_bf16(o0, o1); w.y = cvt_pk_bf16(o2, o3); w.z = cvt_pk_bf16(o4, o5); w.w = cvt_pk_bf16(o6, o7); *(u32x4*)(XB + off + bj * HALF) = w; }
                sq += __shfl_xor(sq, 16); sq += __shfl_xor(sq, 32);
                if (fq == 0) ss[(size_t)r * 16 + u.pn * 4 + wc] = sq;
            }
    }
};

template <class Epi, class Sched, bool ALIGN_EPI = false, bool SP2 = false>
__device__ __forceinline__ void gemm_phase(PG8_LAS unsigned char* lds, const Gemm g, const Sched& S, const Epi& E) {
    int tid_ = threadIdx.x; asm volatile("" : "+v"(tid_));
    const int tid = tid_, wid = __builtin_amdgcn_readfirstlane(tid >> 6), lane = tid & 63, wr = wid >> 2, wc = wid & 3, fr = lane & 15, fq = lane >> 4;
    const int K = g.K, nt = K / BK;
    unsigned voffA[2], voffB[2];
#pragma unroll
    for (int i = 0; i < 2; ++i) { int R, C; stage_rc(tid * 16 + i * 8192, R, C); const int Rb = Epi::PERM ? ((R & ~31) + perm32(R & 31)) : R;
        voffA[i] = (unsigned)(R * K + C) * 2u; voffB[i] = (unsigned)(Rb * K + C) * 2u; }
    const size_t kstep = (size_t)(BK * 2);
    const size_t hstep = (size_t)HALF * K * 2;
    const size_t tstep = 2 * hstep;
    const unsigned ldsw = (unsigned)wid * 1024u;
    const int aoff = lds_byte(wr * 64 + fr, fq * 8), boff = lds_byte(wc * 32 + fr, fq * 8);
#define PG8_SA(b, h) (((b) * 2 + (h)) * HTB)
#define PG8_SB(b, h) ((4 + (b) * 2 + (h)) * HTB)
#define PG8_STAGE(bufoff, gbase, voff) do { _Pragma("unroll") for (int _i = 0; _i < 2; ++_i) \
        __builtin_amdgcn_global_load_lds((const unsigned*)((const char*)(gbase) + (voff)[_i]), (PG8_LAS unsigned*)(lds + (bufoff) + ldsw + _i * 8192), 16, 0, 0); } while (0)
#define PG8_LDA(dst, b, h) do { _Pragma("unroll") for (int m = 0; m < 4; ++m) _Pragma("unroll") for (int k = 0; k < 2; ++k) dst[m][k] = *(const PG8_LAS bf16x8*)(lds + PG8_SA(b, h) + aoff + m * 2048 + k * 1024); } while (0)
#define PG8_LDB(dst, b, h) do { _Pragma("unroll") for (int n = 0; n < 2; ++n) _Pragma("unroll") for (int k = 0; k < 2; ++k) dst[n][k] = *(const PG8_LAS bf16x8*)(lds + PG8_SB(b, h) + boff + n * 2048 + k * 1024); } while (0)
#define PG8_MMA(ai, bj, At, Bt) do { __builtin_amdgcn_s_setprio(1); _Pragma("unroll") for (int m = 0; m < 4; ++m) _Pragma("unroll") for (int n = 0; n < 2; ++n) _Pragma("unroll") for (int k = 0; k < 2; ++k) \
        acc[ai][bj][m][n] = __builtin_amdgcn_mfma_f32_16x16x32_bf16(Bt[n][k], At[m][k], acc[ai][bj][m][n], 0, 0, 0); __builtin_amdgcn_s_setprio(0); } while (0)
#define PG8_WAIT_V(n) asm volatile("s_waitcnt vmcnt(" #n ")" ::: "memory")
#define PG8_WAIT_L(n) asm volatile("s_waitcnt lgkmcnt(" #n ")" ::: "memory")
#define PG8_BAR __builtin_amdgcn_s_barrier()
#define PG8_SCHED __builtin_amdgcn_sched_barrier(0)
    Unit cur, nxt; int ui = 0;
    if (!S.next(0, cur)) return;
    f32x4 acc[2][2][4][2];
#pragma unroll
    for (int a = 0; a < 2; ++a)
#pragma unroll
        for (int b = 0; b < 2; ++b)
#pragma unroll
            for (int m = 0; m < 4; ++m)
#pragma unroll
                for (int n = 0; n < 2; ++n) acc[a][b][m][n] = (f32x4){0.f, 0.f, 0.f, 0.f};
    bf16x8 At[4][2], B0[2][2], B1[2][2];
    const char* cA = (const char*)g.A + (size_t)cur.pm * tstep; const char* cB = (const char*)g.Bt + (size_t)cur.pn * tstep;
    S.a_ready(cur);
    if constexpr (SP2) {
        PG8_STAGE(PG8_SB(0, 0), cB, voffB); PG8_STAGE(PG8_SB(0, 1), cB + hstep, voffB); PG8_STAGE(PG8_SA(0, 0), cA, voffA); PG8_STAGE(PG8_SA(0, 1), cA + hstep, voffA);
        if (wr == 1) PG8_BAR;
        PG8_WAIT_V(2); PG8_BAR;
        PG8_STAGE(PG8_SB(1, 0), cB + kstep, voffB); PG8_STAGE(PG8_SA(1, 0), cA + kstep, voffA); PG8_STAGE(PG8_SB(1, 1), cB + hstep + kstep, voffB);
        PG8_WAIT_V(6); PG8_BAR;
    } else {
        PG8_STAGE(PG8_SB(0, 0), cB, voffB); PG8_STAGE(PG8_SA(0, 0), cA, voffA); PG8_STAGE(PG8_SB(0, 1), cB + hstep, voffB); PG8_STAGE(PG8_SA(0, 1), cA + hstep, voffA);
        if (wr == 1) PG8_BAR;
        PG8_WAIT_V(4); PG8_BAR;
        PG8_STAGE(PG8_SB(1, 0), cB + kstep, voffB); PG8_STAGE(PG8_SA(1, 0), cA + kstep, voffA); PG8_STAGE(PG8_SB(1, 1), cB + hstep + kstep, voffB);
        PG8_WAIT_V(6); PG8_BAR;
    }
    for (;;) {
        const bool has_next = S.next(ui + 1, nxt);
        const char* nA = has_next ? (const char*)g.A + (size_t)nxt.pm * tstep : cA; const char* nB = has_next ? (const char*)g.Bt + (size_t)nxt.pn * tstep : cB;
        for (int t = 0; t < nt; t += 2) {
            const bool last = (t == nt - 2);
            const char* a1 = cA + (size_t)(t + 1) * kstep;
            const char* a2 = last ? nA : cA + (size_t)(t + 2) * kstep; const char* b2 = last ? nB : cB + (size_t)(t + 2) * kstep;
            const char* a3 = a2 + kstep; const char* b3 = b2 + kstep;
            if (last && has_next) S.a_ready(nxt);
            if constexpr (SP2) {
            PG8_LDB(B0, 0, 0); PG8_LDB(B1, 0, 1); PG8_SCHED; PG8_LDA(At, 0, 0); PG8_STAGE(PG8_SA(1, 1), a1 + hstep, voffA);
            PG8_WAIT_V(8); PG8_WAIT_L(0); PG8_BAR; PG8_MMA(0, 0, At, B0); PG8_MMA(0, 1, At, B1); PG8_BAR; PG8_SCHED;
            PG8_LDA(At, 0, 1); PG8_STAGE(PG8_SB(0, 0), b2, voffB); PG8_STAGE(PG8_SB(0, 1), b2 + hstep, voffB); PG8_STAGE(PG8_SA(0, 0), a2, voffA);
            PG8_WAIT_V(8); PG8_WAIT_L(0); PG8_BAR; PG8_MMA(1, 0, At, B0); PG8_MMA(1, 1, At, B1); PG8_BAR; PG8_SCHED;
            PG8_LDB(B0, 1, 0); PG8_LDB(B1, 1, 1); PG8_SCHED; PG8_LDA(At, 1, 0); PG8_STAGE(PG8_SA(0, 1), a2 + hstep, voffA);
            PG8_WAIT_V(8); PG8_WAIT_L(0); PG8_BAR; PG8_MMA(0, 0, At, B0); PG8_MMA(0, 1, At, B1); PG8_BAR; PG8_SCHED;
            PG8_LDA(At, 1, 1); PG8_STAGE(PG8_SB(1, 0), b3, voffB); PG8_STAGE(PG8_SB(1, 1), b3 + hstep, voffB); PG8_STAGE(PG8_SA(1, 0), a3, voffA);
            PG8_WAIT_V(8); PG8_WAIT_L(0); PG8_BAR; PG8_MMA(1, 0, At, B0); PG8_MMA(1, 1, At, B1); PG8_BAR; PG8_SCHED;
            } else {
            PG8_LDB(B0, 0, 0); PG8_SCHED; PG8_LDA(At, 0, 0); PG8_STAGE(PG8_SA(1, 1), a1 + hstep, voffA);
            PG8_WAIT_L(8); PG8_BAR; PG8_WAIT_L(0); PG8_MMA(0, 0, At, B0); PG8_BAR; PG8_SCHED;
            PG8_LDB(B1, 0, 1); PG8_STAGE(PG8_SB(0, 0), b2, voffB);
            PG8_BAR; PG8_WAIT_L(0); PG8_MMA(0, 1, At, B1); PG8_BAR;
            PG8_LDA(At, 0, 1); PG8_STAGE(PG8_SA(0, 0), a2, voffA);
            PG8_BAR; PG8_WAIT_L(0); PG8_MMA(1, 0, At, B0); PG8_BAR; PG8_SCHED;
            PG8_STAGE(PG8_SB(0, 1), b2 + hstep, voffB);
            PG8_WAIT_V(6); PG8_BAR; PG8_MMA(1, 1, At, B1); PG8_BAR;
            PG8_LDB(B0, 1, 0); PG8_SCHED; PG8_LDA(At, 1, 0); PG8_STAGE(PG8_SA(0, 1), a2 + hstep, voffA);
            PG8_WAIT_L(8); PG8_BAR; PG8_WAIT_L(0); PG8_MMA(0, 0, At, B0); PG8_BAR; PG8_SCHED;
            PG8_LDB(B1, 1, 1); PG8_STAGE(PG8_SB(1, 0), b3, voffB);
            PG8_BAR; PG8_WAIT_L(0); PG8_MMA(0, 1, At, B1); PG8_BAR;
            PG8_LDA(At, 1, 1); PG8_STAGE(PG8_SA(1, 0), a3, voffA);
            PG8_BAR; PG8_WAIT_L(0); PG8_MMA(1, 0, At, B0); PG8_BAR; PG8_SCHED;
            PG8_STAGE(PG8_SB(1, 1), b3 + hstep, voffB);
            PG8_WAIT_V(6); PG8_BAR; PG8_MMA(1, 1, At, B1); PG8_BAR;
            }
        }
        if constexpr (ALIGN_EPI) { if (wr == 0) PG8_BAR; }
        if constexpr (!Epi::AFTER_DRAIN) { E(acc, cur, wr, wc, fr, fq); S.done(cur); }
        if (!has_next) break;
#pragma unroll
        for (int a = 0; a < 2; ++a)
#pragma unroll
            for (int b = 0; b < 2; ++b)
#pragma unroll
                for (int m = 0; m < 4; ++m)
#pragma unroll
                    for (int n = 0; n < 2; ++n) acc[a][b][m][n] = (f32x4){0.f, 0.f, 0.f, 0.f};
        cur = nxt; cA = nA; cB = nB; ++ui;
        if constexpr (ALIGN_EPI) { if (wr == 1) PG8_BAR; }
    }
    PG8_WAIT_V(0);
    if constexpr (!ALIGN_EPI) { if (wr == 0) PG8_BAR; }
    PG8_BAR;
    if constexpr (Epi::AFTER_DRAIN) { E.fused(acc, cur, wr, wc, fr, fq, lds, wid, lane); S.done(cur); }
#undef PG8_SA
#undef PG8_SB
#undef PG8_STAGE
#undef PG8_LDA
#undef PG8_LDB
#undef PG8_MMA
#undef PG8_WAIT_V
#undef PG8_WAIT_L
#undef PG8_BAR
#undef PG8_SCHED
}
}

#ifndef MK_SINGLE
#define MK_SINGLE 1
#endif
constexpr int NWAVES = 8;
constexpr int M = 16384, D = 1024, INW = 3328, FF = 4096, SEQ = 8192, NH = 6, HD = 128, PW = 256, DEPTH = 4, HW = 768;
constexpr int SEGL = 512, NSEG = SEQ / SEGL, NCH = SEGL / 64, NHITEMS = 2 * NH * NSEG;
constexpr int NPOOL = M / 256;
constexpr float EPS = 1e-5f;
constexpr int NPHASES = 2 + 5 * DEPTH;
constexpr size_t MiB = 1u << 20;
constexpr size_t WS_BAR = 0, BAR_ZERO_BYTES = 16384 + 256 * 256;
constexpr size_t WS_PFLAG = 16384;
constexpr size_t WS_LB = 1 * MiB;
constexpr size_t WS_WIN = 2 * MiB, WS_WOUT = 9 * MiB, WS_WUP = 11 * MiB, WS_WDN = 19 * MiB;
constexpr size_t WS_XB = 27 * MiB, WS_Y = 59 * MiB;
constexpr size_t WS_SEGS = 91 * MiB, WS_SEGD = 103 * MiB;
constexpr size_t WS_U = 104 * MiB;
constexpr size_t WS_SS = 232 * MiB;
constexpr size_t WS_WIN2 = 241 * MiB;
constexpr size_t WS_END = 248 * MiB;
static_assert(WS_SS + 9 * (size_t)M * 64 <= WS_END && WS_WIN + (size_t)INW * D * 2 <= WS_WOUT && WS_SEGS + (size_t)NHITEMS * 65536 <= WS_SEGD && WS_U + (size_t)M * FF * 2 <= WS_SS && WS_SS + 9 * (size_t)M * 64 <= WS_WIN2 && WS_WIN2 + (size_t)INW * D * 2 <= WS_END, "ws map");
constexpr int LDS_BYTES = 147456;
constexpr int MISC_OFF = 131072;
constexpr int QP = 136, SP = 72, OP = 132;
constexpr int Q_OFF = 0, KT_OFF = 17408, OB_OFF = 0  , KH_OFF = 34816, VT_OFF = 53248, ST_OFF = 71680, PM_OFF = 106496, TOT_OFF = 115712, DV_OFF = 119808, DS_OFF = 120320;
static_assert(64 * OP * 4 <= KH_OFF && DS_OFF + 512 <= 131072, "mixer LDS map");
constexpr int PPP = 264;
constexpr int PP_OFF = 0, WT_OFF = 128 * PPP * 2;
static_assert(WT_OFF + 256 * SP * 2 <= 131072, "pool LDS map");

#define LAS __attribute__((address_space(3)))
#define GAS __attribute__((address_space(1)))
typedef unsigned short bf16;
typedef float f32x4 __attribute__((ext_vector_type(4)));
typedef float f32x2 __attribute__((ext_vector_type(2)));
typedef short bf16x8 __attribute__((ext_vector_type(8)));
typedef unsigned u32x4 __attribute__((ext_vector_type(4)));
typedef unsigned u32x2 __attribute__((ext_vector_type(2)));
typedef __bf16 bf16x2_t __attribute__((ext_vector_type(2)));
__device__ __forceinline__ unsigned pk2(float lo, float hi) { f32x2 v = {lo, hi}; bf16x2_t b = __builtin_convertvector(v, bf16x2_t); return __builtin_bit_cast(unsigned, b); }
__device__ __forceinline__ float bflo(unsigned u) { return __uint_as_float(u << 16); }
__device__ __forceinline__ float bfhi(unsigned u) { return __uint_as_float(u & 0xffff0000u); }
__device__ __forceinline__ float wave_sum(float v) {
#pragma unroll
    for (int o = 1; o < 64; o <<= 1) v += __shfl_xor(v, o);
    return v;
}
#define MFMA16(a, b, c) __builtin_amdgcn_mfma_f32_16x16x32_bf16((a), (b), (c), 0, 0, 0)

__device__ __forceinline__ void transpose_load(const float* W, int K, int N, int item, int lane, f32x4 (&v)[8]) {
    const int nblk = N / 32, kb = item / nblk, nb = item % nblk, k0 = 64 * kb, n0 = 32 * nb;
    const int kr = lane >> 3, nq = lane & 7;
    const GAS float* Wg = (const GAS float*)W + (size_t)(k0 + kr) * N + n0 + 4 * nq;
#pragma unroll
    for (int i = 0; i < 8; ++i) v[i] = *(const GAS f32x4*)(Wg + (size_t)(8 * i) * N);
}
__device__ __forceinline__ void transpose_finish(f32x4 (&v)[8], const float* g, int K, int N, bf16* WT, LAS float* scr, int item, int lane) {
    const int nblk = N / 32, kb = item / nblk, nb = item % nblk, k0 = 64 * kb, n0 = 32 * nb;
    const int kr = lane >> 3, nq = lane & 7;
    if (g) {
#pragma unroll
        for (int i = 0; i < 8; ++i) v[i] = v[i] * g[k0 + 8 * i + kr];
    }
#pragma unroll
    for (int i = 0; i < 8; ++i) { LAS float* d = scr + (8 * i + kr) * 33 + 4 * nq; d[0] = v[i][0]; d[1] = v[i][1]; d[2] = v[i][2]; d[3] = v[i][3]; }
    asm volatile("s_waitcnt lgkmcnt(0)" ::: "memory");
    const int c = lane & 7;
#pragma unroll
    for (int j = 0; j < 4; ++j) { const int n = (lane >> 3) + 8 * j; const LAS float* s = scr + (8 * c) * 33 + n;
        u32x4 o; o.x = pk2(s[0 * 33], s[1 * 33]); o.y = pk2(s[2 * 33], s[3 * 33]); o.z = pk2(s[4 * 33], s[5 * 33]); o.w = pk2(s[6 * 33], s[7 * 33]);
        *(GAS u32x4*)(WT + (size_t)(n0 + n) * K + k0 + 8 * c) = o; }
    asm volatile("s_waitcnt lgkmcnt(0)" ::: "memory");
}
__device__ __forceinline__ int convert_one(LAS unsigned char* lds, const float* W, const float* g, bf16* WT, int K, int N, int base, int gw, int ngw, int wave, int lane) {
    LAS float* scr = (LAS float*)(lds + wave * 16384);
    const int nit = (K / 64) * (N / 32);
    int it = (gw - base % ngw + ngw) % ngw;
#pragma unroll 1
    for (; it < nit; it += 4 * ngw) {
        f32x4 va[8], vb[8], vc[8], vd[8];
        const int i1 = it + ngw, i2 = it + 2 * ngw, i3 = it + 3 * ngw;
        transpose_load(W, K, N, it, lane, va);
        if (i1 < nit) transpose_load(W, K, N, i1, lane, vb);
        if (i2 < nit) transpose_load(W, K, N, i2, lane, vc);
        if (i3 < nit) transpose_load(W, K, N, i3, lane, vd);
        transpose_finish(va, g, K, N, WT, scr, it, lane);
        if (i1 < nit) transpose_finish(vb, g, K, N, WT, scr, i1, lane);
        if (i2 < nit) transpose_finish(vc, g, K, N, WT, scr, i2, lane);
        if (i3 < nit) transpose_finish(vd, g, K, N, WT, scr, i3, lane);
    }
    return base + nit;
}

#define XB_TMO      128
#define XB_XCNT(j)  (256  + 64 * (j))
#define XB_XSUB(j)  (1280 + 64 * (j))
#define XB_XGEN(j)  (2304 + 64 * (j))
#define XB_TOP      3328
#define XB_TOPGEN   3392
#define XCD_BAR_WORDS 3456
#define XB_SPIN_CAP (1u << 18)

__device__ __forceinline__ unsigned xb_ld(unsigned* p)              { return __hip_atomic_load(p, __ATOMIC_RELAXED, __HIP_MEMORY_SCOPE_AGENT); }
__device__ __forceinline__ unsigned xb_add(unsigned* p, unsigned v) { return __hip_atomic_fetch_add(p, v, __ATOMIC_RELAXED, __HIP_MEMORY_SCOPE_AGENT); }
__device__ __forceinline__ unsigned xb_xcc_id() { return (unsigned)__builtin_amdgcn_s_getreg((3 << 11) | 20) & 0xFu; }
#define XB_SPIN(cond, bar) do { unsigned _sp = 0; while (cond) { __builtin_amdgcn_s_sleep(1); \
    if ((++_sp & 255u) == 0u) { if (xb_ld(&(bar)[XB_TMO])) break; if (_sp > XB_SPIN_CAP) { atomicAdd(&(bar)[XB_TMO], 1u); break; } } } } while (0)

struct XcdBarrier {
    unsigned* bar; unsigned x;
    volatile LAS unsigned* st;
};

__device__ __forceinline__ XcdBarrier xcd_barrier_post(unsigned* bar, volatile LAS unsigned* st) {
    XcdBarrier b; b.bar = bar; b.x = xb_xcc_id(); b.st = st;
    if (threadIdx.x == 0) (void)xb_add(&bar[XB_XCNT(b.x)], 1u);
    return b;
}
__device__ __forceinline__ void xcd_barrier_complete(unsigned* bar, unsigned x, unsigned& nloc, unsigned& nx) {
    const unsigned G = gridDim.x * gridDim.y * gridDim.z;
    unsigned sum, cnt, mine, sp = 0u;
    for (;;) {
        sum = 0u; cnt = 0u; mine = 0u;
#pragma unroll
        for (unsigned j = 0; j < 16; ++j) { const unsigned c = xb_ld(&bar[XB_XCNT(j)]); sum += c; cnt += (c > 0u) ? 1u : 0u; mine = (j == x) ? c : mine; }
        if (sum == G) break;
        __builtin_amdgcn_s_sleep(1);
        if ((++sp & 255u) == 0u) { if (xb_ld(&bar[XB_TMO])) break; if (sp > XB_SPIN_CAP) { atomicAdd(&bar[XB_TMO], 1u); break; } }
    }
    nloc = mine > 0u ? mine : 1u; nx = cnt > 0u ? cnt : 1u;
}

__device__ __forceinline__ void xcd_barrier(const XcdBarrier& b) {
    asm volatile("s_waitcnt vmcnt(0)" ::: "memory");
    __syncthreads();
    if (threadIdx.x == 0) {
        unsigned* bar = b.bar;
        __builtin_amdgcn_s_waitcnt(0);
        unsigned nloc = b.st[0], nx = b.st[1];
        if (nloc == 0u) { xcd_barrier_complete(bar, b.x, nloc, nx); b.st[0] = nloc; b.st[1] = nx; }
        const unsigned old = xb_add(&bar[XB_XSUB(b.x)], 1u);
        const unsigned gen = old / nloc;
        if (old + 1u == (gen + 1u) * nloc) {
            __builtin_amdgcn_fence(__ATOMIC_RELEASE, "agent");
            asm volatile("s_waitcnt vmcnt(0)" ::: "memory");
            const unsigned og = xb_add(&bar[XB_TOP], 1u);
            const unsigned tg = og / nx;
            if (og + 1u == (tg + 1u) * nx) xb_add(&bar[XB_TOPGEN], 1u);
            else XB_SPIN(xb_ld(&bar[XB_TOPGEN]) == tg, bar);
            __builtin_amdgcn_fence(__ATOMIC_ACQUIRE, "agent");
            xb_add(&bar[XB_XGEN(b.x)], 1u);
            asm volatile("s_waitcnt vmcnt(0)" ::: "memory");
        } else {
            XB_SPIN(xb_ld(&bar[XB_XGEN(b.x)]) == gen, bar);
            __builtin_amdgcn_fence(__ATOMIC_ACQUIRE, "agent");
            asm volatile("s_waitcnt vmcnt(0)" ::: "memory");
        }
    }
    __syncthreads();
}

template <bool FULL>
__device__ __forceinline__ void hgrn_item(LAS unsigned char* lds, const bf16* U, bf16* Y, float* SEGS, float* SEGD, const float* normg, int item, int tid) {
    const int lane = tid & 63, w = __builtin_amdgcn_readfirstlane(tid >> 6), fr = lane & 15, fq = lane >> 4;
    const int j = item % NSEG, bh = item / NSEG, h = bh % NH, b = bh / NH;
    if (!FULL && j == NSEG - 1) return;
    const int row0 = b * SEQ + j * SEGL;
    LAS bf16* Qs = (LAS bf16*)(lds + Q_OFF); LAS bf16* KT = (LAS bf16*)(lds + KT_OFF); LAS bf16* KH = (LAS bf16*)(lds + KH_OFF); LAS bf16* VT = (LAS bf16*)(lds + VT_OFF);
    LAS bf16* ST = (LAS bf16*)(lds + ST_OFF); LAS bf16* PM = (LAS bf16*)(lds + PM_OFF); LAS float* OB = (LAS float*)(lds + OB_OFF);
    LAS float* TOT = (LAS float*)(lds + TOT_OFF); LAS float* DV = (LAS float*)(lds + DV_OFF); LAS float* DS = (LAS float*)(lds + DS_OFF);
    f32x4 S[8];
#pragma unroll
    for (int vt = 0; vt < 8; ++vt) S[vt] = (f32x4){0.f, 0.f, 0.f, 0.f};
    if (tid < 128) DS[tid] = 0.f;
    f32x4 n0 = (f32x4){0.f, 0.f, 0.f, 0.f}, n1 = n0, n2 = n0, n3 = n0;
    if constexpr (FULL) { const GAS float* ng = (const GAS float*)normg + h * HD + (tid & 7) * 16; n0 = *(const GAS f32x4*)ng; n1 = *(const GAS f32x4*)(ng + 4); n2 = *(const GAS f32x4*)(ng + 8); n3 = *(const GAS f32x4*)(ng + 12); }
    unsigned lf2[8], v2[8], q2[8];
#define HG_LOAD(cc) do { const GAS bf16* up_ = (const GAS bf16*)U + (size_t)(row0 + (cc) * 64 + 8 * w) * INW + h * HD + 2 * lane; _Pragma("unroll") for (int jj = 0; jj < 8; ++jj) { \
        lf2[jj] = *(const GAS unsigned*)(up_ + (size_t)jj * INW + 1024); v2[jj] = *(const GAS unsigned*)(up_ + (size_t)jj * INW + 1792); q2[jj] = FULL ? *(const GAS unsigned*)(up_ + (size_t)jj * INW + 256) : 0u; } } while (0)
    HG_LOAD(FULL ? 0 : NCH - 1);
    if (FULL) {
        f32x4 P = (f32x4){1.f, 1.f, 1.f, 1.f};
        for (int i = j - 1; i >= 0; --i) {
            const GAS float* Ki = (const GAS float*)SEGS + (size_t)(bh * NSEG + i) * 16384; const f32x4 dv = *(const GAS f32x4*)((const GAS float*)SEGD + (size_t)(bh * NSEG + i) * 128 + 16 * w + 4 * fq);
            f32x4 kv[8];
#pragma unroll
            for (int vt = 0; vt < 8; ++vt) kv[vt] = *(const GAS f32x4*)(Ki + (size_t)((vt * 8 + w) * 64 + lane) * 4);
#pragma unroll
            for (int vt = 0; vt < 8; ++vt) S[vt] = S[vt] + P * kv[vt];
            P = P * dv;
            if (__ballot((P[0] != 0.f) | (P[1] != 0.f) | (P[2] != 0.f) | (P[3] != 0.f)) == 0ull) break;
        }
#pragma unroll
        for (int vt = 0; vt < 8; ++vt) { u32x2 o; o.x = pk2(S[vt][0], S[vt][1]); o.y = pk2(S[vt][2], S[vt][3]); *(LAS u32x2*)(ST + (16 * vt + fr) * QP + 16 * w + 4 * fq) = o; }
    }
    __syncthreads();
    float run0 = 1.f, run1 = 1.f;
    if constexpr (!FULL) {
        for (int c = NCH - 1; c >= 0; --c) {
            float f0[8], f1[8]; float a0 = 0.f, a1 = 0.f;
#pragma unroll
            for (int jj = 0; jj < 8; ++jj) { const float l0 = bflo(lf2[jj]), l1 = bfhi(lf2[jj]); a0 += l0; a1 += l1; f0[jj] = __expf(l0); f1[jj] = __expf(l1); }
            *(LAS f32x2*)(TOT + w * 128 + 2 * lane) = (f32x2){a0, a1};
            __syncthreads();
            float p0 = 0.f, p1 = 0.f, t0 = 0.f, t1 = 0.f;
#pragma unroll
            for (int g = 0; g < 8; ++g) { const f32x2 tv = *(const LAS f32x2*)(TOT + g * 128 + 2 * lane); if (g < w) { p0 += tv.x; p1 += tv.y; } t0 += tv.x; t1 += tv.y; }
            float kh0[8], kh1[8];
            { float gs0 = __expf(t0 - p0 - a0) * run0, gs1 = __expf(t1 - p1 - a1) * run1;
#pragma unroll
              for (int jj = 7; jj >= 0; --jj) { kh0[jj] = (1.0f - f0[jj]) * gs0; kh1[jj] = (1.0f - f1[jj]) * gs1; gs0 *= f0[jj]; gs1 *= f1[jj]; } }
            { u32x4 o; o.x = pk2(kh0[0], kh0[1]); o.y = pk2(kh0[2], kh0[3]); o.z = pk2(kh0[4], kh0[5]); o.w = pk2(kh0[6], kh0[7]); *(LAS u32x4*)(KH + (2 * lane) * SP + 8 * w) = o;
              o.x = pk2(kh1[0], kh1[1]); o.y = pk2(kh1[2], kh1[3]); o.z = pk2(kh1[4], kh1[5]); o.w = pk2(kh1[6], kh1[7]); *(LAS u32x4*)(KH + (2 * lane + 1) * SP + 8 * w) = o;
              o.x = (v2[0] & 0xffffu) | (v2[1] << 16); o.y = (v2[2] & 0xffffu) | (v2[3] << 16); o.z = (v2[4] & 0xffffu) | (v2[5] << 16); o.w = (v2[6] & 0xffffu) | (v2[7] << 16); *(LAS u32x4*)(VT + (2 * lane) * SP + 8 * w) = o;
              o.x = (v2[0] >> 16) | (v2[1] & 0xffff0000u); o.y = (v2[2] >> 16) | (v2[3] & 0xffff0000u); o.z = (v2[4] >> 16) | (v2[5] & 0xffff0000u); o.w = (v2[6] >> 16) | (v2[7] & 0xffff0000u); *(LAS u32x4*)(VT + (2 * lane + 1) * SP + 8 * w) = o; }
            run0 *= __expf(t0); run1 *= __expf(t1);
            const bool more = c > 0 && __ballot((run0 != 0.f) | (run1 != 0.f)) != 0ull;
            if (more) HG_LOAD(c - 1);
            __syncthreads();
            { bf16x8 kf[2];
#pragma unroll
              for (int kk = 0; kk < 2; ++kk) kf[kk] = *(const LAS bf16x8*)(KH + (16 * w + fr) * SP + kk * 32 + 8 * fq);
#pragma unroll
              for (int vt = 0; vt < 8; ++vt) {
#pragma unroll
                  for (int kk = 0; kk < 2; ++kk) { const bf16x8 vf = *(const LAS bf16x8*)(VT + (vt * 16 + fr) * SP + kk * 32 + 8 * fq); S[vt] = MFMA16(kf[kk], vf, S[vt]); } } }
            if (!more) break;
        }
    }
    if constexpr (FULL) for (int c = 0; c < NCH; ++c) {
        const int r0 = row0 + c * 64;
        float f0[8], f1[8]; float a0 = 0.f, a1 = 0.f;
#pragma unroll
        for (int jj = 0; jj < 8; ++jj) { const float l0 = bflo(lf2[jj]), l1 = bfhi(lf2[jj]); a0 += l0; a1 += l1; f0[jj] = __expf(l0); f1[jj] = __expf(l1); }
        *(LAS f32x2*)(TOT + w * 128 + 2 * lane) = (f32x2){a0, a1};
        __syncthreads();
        float p0 = 0.f, p1 = 0.f, t0 = 0.f, t1 = 0.f;
#pragma unroll
        for (int g = 0; g < 8; ++g) { const f32x2 tv = *(const LAS f32x2*)(TOT + g * 128 + 2 * lane); if (g < w) { p0 += tv.x; p1 += tv.y; } t0 += tv.x; t1 += tv.y; }
        if (w == 0) { *(LAS f32x2*)(DV + 2 * lane) = (f32x2){__expf(t0), __expf(t1)}; const f32x2 ds = *(const LAS f32x2*)(DS + 2 * lane); *(LAS f32x2*)(DS + 2 * lane) = (f32x2){ds.x + t0, ds.y + t1}; }
        float kh0[8], kh1[8];
        {
          float gs0 = __expf(t0 - p0 - a0), gs1 = __expf(t1 - p1 - a1);
#pragma unroll
          for (int jj = 7; jj >= 0; --jj) { kh0[jj] = (1.0f - f0[jj]) * gs0; kh1[jj] = (1.0f - f1[jj]) * gs1; gs0 *= f0[jj]; gs1 *= f1[jj]; } }
        if (FULL) {
            float e0 = __expf(fmaxf(p0, -80.f)), e1 = __expf(fmaxf(p1, -80.f));
#pragma unroll
            for (int jj = 0; jj < 8; ++jj) {
                e0 = fmaxf(e0 * f0[jj], 1.8049e-35f); e1 = fmaxf(e1 * f1[jj], 1.8049e-35f);
                const float i0 = __builtin_amdgcn_rcpf(e0), i1 = __builtin_amdgcn_rcpf(e1);
                *(LAS unsigned*)(Qs + (8 * w + jj) * QP + 2 * lane) = pk2(bflo(q2[jj]) * e0, bfhi(q2[jj]) * e1);
                *(LAS unsigned*)(KT + (8 * w + jj) * QP + 2 * lane) = pk2((1.0f - f0[jj]) * i0, (1.0f - f1[jj]) * i1);
            }
        }
        { u32x4 o; o.x = pk2(kh0[0], kh0[1]); o.y = pk2(kh0[2], kh0[3]); o.z = pk2(kh0[4], kh0[5]); o.w = pk2(kh0[6], kh0[7]); *(LAS u32x4*)(KH + (2 * lane) * SP + 8 * w) = o;
          o.x = pk2(kh1[0], kh1[1]); o.y = pk2(kh1[2], kh1[3]); o.z = pk2(kh1[4], kh1[5]); o.w = pk2(kh1[6], kh1[7]); *(LAS u32x4*)(KH + (2 * lane + 1) * SP + 8 * w) = o;
          o.x = (v2[0] & 0xffffu) | (v2[1] << 16); o.y = (v2[2] & 0xffffu) | (v2[3] << 16); o.z = (v2[4] & 0xffffu) | (v2[5] << 16); o.w = (v2[6] & 0xffffu) | (v2[7] << 16); *(LAS u32x4*)(VT + (2 * lane) * SP + 8 * w) = o;
          o.x = (v2[0] >> 16) | (v2[1] & 0xffff0000u); o.y = (v2[2] >> 16) | (v2[3] & 0xffff0000u); o.z = (v2[4] >> 16) | (v2[5] & 0xffff0000u); o.w = (v2[6] >> 16) | (v2[7] & 0xffff0000u); *(LAS u32x4*)(VT + (2 * lane + 1) * SP + 8 * w) = o; }
        const int t_e = tid >> 3, vs_e = (tid & 7) * 16;
        u32x4 g0 = (u32x4){0u, 0u, 0u, 0u}, g1 = g0;
        if constexpr (FULL) { const GAS bf16* gp = (const GAS bf16*)U + (size_t)(r0 + t_e) * INW + 2560 + h * HD + vs_e; g0 = *(const GAS u32x4*)gp; g1 = *(const GAS u32x4*)(gp + 8); }
        if (c + 1 < NCH) HG_LOAD(c + 1);
        __syncthreads();
        const int tt = w >> 1;
        f32x4 oa[4];
        if constexpr (FULL) {
#pragma unroll
            for (int ti = 0; ti < 2; ++ti) { const int ts = (w & 1) * 2 + ti; f32x4 pa = (f32x4){0.f, 0.f, 0.f, 0.f};
                if (ts <= tt) {
#pragma unroll
                    for (int kk = 0; kk < 4; ++kk) { const bf16x8 a = *(const LAS bf16x8*)(KT + (ts * 16 + fr) * QP + kk * 32 + 8 * fq); const bf16x8 bq = *(const LAS bf16x8*)(Qs + (tt * 16 + fr) * QP + kk * 32 + 8 * fq); pa = MFMA16(a, bq, pa); }
                    if (ts == tt) {
#pragma unroll
                        for (int i = 0; i < 4; ++i) if (4 * fq + i > fr) pa[i] = 0.f;
                    }
                }
                u32x2 o; o.x = pk2(pa[0], pa[1]); o.y = pk2(pa[2], pa[3]); *(LAS u32x2*)(PM + (tt * 16 + fr) * SP + ts * 16 + 4 * fq) = o; }
            bf16x8 qf[4];
#pragma unroll
            for (int kk = 0; kk < 4; ++kk) qf[kk] = *(const LAS bf16x8*)(Qs + (tt * 16 + fr) * QP + kk * 32 + 8 * fq);
#pragma unroll
            for (int vi = 0; vi < 4; ++vi) { const int vt = (w & 1) * 4 + vi; oa[vi] = (f32x4){0.f, 0.f, 0.f, 0.f};
#pragma unroll
                for (int kk = 0; kk < 4; ++kk) { const bf16x8 sf = *(const LAS bf16x8*)(ST + (vt * 16 + fr) * QP + kk * 32 + 8 * fq); oa[vi] = MFMA16(sf, qf[kk], oa[vi]); } }
            __syncthreads();
            bf16x8 pf[2];
#pragma unroll
            for (int kk = 0; kk < 2; ++kk) pf[kk] = *(const LAS bf16x8*)(PM + (tt * 16 + fr) * SP + kk * 32 + 8 * fq);
#pragma unroll
            for (int vi = 0; vi < 4; ++vi) { const int vt = (w & 1) * 4 + vi;
#pragma unroll
                for (int kk = 0; kk < 2; ++kk) { const bf16x8 vf = *(const LAS bf16x8*)(VT + (vt * 16 + fr) * SP + kk * 32 + 8 * fq); oa[vi] = MFMA16(vf, pf[kk], oa[vi]); } }
        }
        { const f32x4 dv = *(const LAS f32x4*)(DV + 16 * w + 4 * fq); bf16x8 kf[2];
#pragma unroll
          for (int kk = 0; kk < 2; ++kk) kf[kk] = *(const LAS bf16x8*)(KH + (16 * w + fr) * SP + kk * 32 + 8 * fq);
#pragma unroll
          for (int vt = 0; vt < 8; ++vt) { S[vt] = S[vt] * dv;
#pragma unroll
              for (int kk = 0; kk < 2; ++kk) { const bf16x8 vf = *(const LAS bf16x8*)(VT + (vt * 16 + fr) * SP + kk * 32 + 8 * fq); S[vt] = MFMA16(kf[kk], vf, S[vt]); } } }
        if constexpr (FULL) {
#pragma unroll
            for (int vt = 0; vt < 8; ++vt) { u32x2 o; o.x = pk2(S[vt][0], S[vt][1]); o.y = pk2(S[vt][2], S[vt][3]); *(LAS u32x2*)(ST + (16 * vt + fr) * QP + 16 * w + 4 * fq) = o; }
#pragma unroll
            for (int vi = 0; vi < 4; ++vi) { const int vt = (w & 1) * 4 + vi; *(LAS f32x4*)(OB + (tt * 16 + fr) * OP + vt * 16 + 4 * fq) = oa[vi]; }
            __syncthreads();
            const int t = t_e, vs = vs_e;
            f32x4 o4[4]; float ssq = 0.f;
#pragma unroll
            for (int q = 0; q < 4; ++q) { o4[q] = *(const LAS f32x4*)(OB + t * OP + vs + 4 * q); ssq += (o4[q][0] * o4[q][0] + o4[q][1] * o4[q][1]) + (o4[q][2] * o4[q][2] + o4[q][3] * o4[q][3]); }
            ssq += __shfl_xor(ssq, 1); ssq += __shfl_xor(ssq, 2); ssq += __shfl_xor(ssq, 4);
            const float rs = rsqrtf(ssq * (1.0f / 128.0f) + EPS);
            u32x4 y0, y1;
            y0.x = pk2(o4[0][0] * rs * n0[0] * bflo(g0.x), o4[0][1] * rs * n0[1] * bfhi(g0.x)); y0.y = pk2(o4[0][2] * rs * n0[2] * bflo(g0.y), o4[0][3] * rs * n0[3] * bfhi(g0.y));
            y0.z = pk2(o4[1][0] * rs * n1[0] * bflo(g0.z), o4[1][1] * rs * n1[1] * bfhi(g0.z)); y0.w = pk2(o4[1][2] * rs * n1[2] * bflo(g0.w), o4[1][3] * rs * n1[3] * bfhi(g0.w));
            y1.x = pk2(o4[2][0] * rs * n2[0] * bflo(g1.x), o4[2][1] * rs * n2[1] * bfhi(g1.x)); y1.y = pk2(o4[2][2] * rs * n2[2] * bflo(g1.y), o4[2][3] * rs * n2[3] * bfhi(g1.y));
            y1.z = pk2(o4[3][0] * rs * n3[0] * bflo(g1.z), o4[3][1] * rs * n3[1] * bfhi(g1.z)); y1.w = pk2(o4[3][2] * rs * n3[2] * bflo(g1.w), o4[3][3] * rs * n3[3] * bfhi(g1.w));
            GAS bf16* yp = (GAS bf16*)Y + (size_t)(r0 + t) * D + PW + h * HD + vs;
            *(GAS u32x4*)yp = y0; *(GAS u32x4*)(yp + 8) = y1;
        }
    }
    if (!FULL) {
        { const __amdgpu_buffer_rsrc_t srsrc = __builtin_amdgcn_make_buffer_rsrc((void*)SEGS, 0, NHITEMS * 65536, 0x00020000);
#pragma unroll
          for (int vt = 0; vt < 8; ++vt) __builtin_amdgcn_raw_buffer_store_b128(__builtin_bit_cast(u32x4, S[vt]), srsrc, (unsigned)(((size_t)item * 16384 + (size_t)((vt * 8 + w) * 64 + lane) * 4) * 4), 0, 16); }
        if (w == 0) { __hip_atomic_store((GAS float*)SEGD + (size_t)item * 128 + 2 * lane, run0, __ATOMIC_RELAXED, __HIP_MEMORY_SCOPE_AGENT); __hip_atomic_store((GAS float*)SEGD + (size_t)item * 128 + 2 * lane + 1, run1, __ATOMIC_RELAXED, __HIP_MEMORY_SCOPE_AGENT); }
    }
    __syncthreads();
#undef HG_LOAD
}

constexpr int XT_OFF = 0, PPQ_OFF = 41728, WTQ_OFF = 75520, SCL_OFF = 112384;
static_assert(79 * PPP * 2 <= PPQ_OFF && PPQ_OFF + 64 * PPP * 2 <= WTQ_OFF && WTQ_OFF + 256 * SP * 2 <= SCL_OFF && SCL_OFF + 1024 <= 131072, "pool LDS map");
template <int WIN>
__device__ __forceinline__ void pool_win(const LAS bf16* XT, LAS bf16* PP, int run, int tseq0, int g, int pair) {
    const LAS bf16* xp = XT + (run * 16 + 15 - (WIN - 1)) * PPP + g * 64 + 2 * pair;
    unsigned xv[16 + WIN - 1];
#pragma unroll
    for (int i = 0; i < 16 + WIN - 1; ++i) xv[i] = *(const LAS unsigned*)(xp + i * PPP);
    float s0 = 0.f, s1 = 0.f;
#pragma unroll
    for (int i = 0; i < WIN - 1; ++i) { s0 += bflo(xv[i]); s1 += bfhi(xv[i]); }
    LAS bf16* pp = PP + (run * 16) * PPP + g * 64 + 2 * pair;
#pragma unroll
    for (int jj = 0; jj < 16; ++jj) { const float x0 = bflo(xv[jj + WIN - 1]), x1 = bfhi(xv[jj + WIN - 1]); s0 += x0; s1 += x1;
        const int cn = tseq0 + jj + 1; const float ic = 1.0f / (float)(cn < WIN ? cn : WIN);
        *(LAS unsigned*)(pp + jj * PPP) = pk2(s0 * ic - x0, s1 * ic - x1);
        s0 -= bflo(xv[jj]); s1 -= bfhi(xv[jj]); }
}
__device__ __forceinline__ void pool_item(LAS unsigned char* lds, const bf16* U, bf16* Y, const float* poolw, const float* pscale, int item, int tid) {
    const int lane = tid & 63, w = __builtin_amdgcn_readfirstlane(tid >> 6), fr = lane & 15, fq = lane >> 4;
    LAS bf16* XT = (LAS bf16*)(lds + XT_OFF); LAS bf16* PP = (LAS bf16*)(lds + PPQ_OFF); LAS bf16* WT = (LAS bf16*)(lds + WTQ_OFF);
    LAS float* SCL = (LAS float*)(lds + SCL_OFF); if (tid < PW) SCL[tid] = ((const GAS float*)pscale)[tid];
    const int Rb = item * 256, bstart = (Rb / SEQ) * SEQ;
    u32x4 xr[5];
#define PL_LOAD(qq) do { _Pragma("unroll") for (int i = 0; i < 5; ++i) { const int ch = tid + 512 * i, row = ch >> 5, cc = ch & 31, tg = Rb + (qq) * 64 - 15 + row; \
        xr[i] = (ch < 79 * 32 && tg >= bstart) ? *(const GAS u32x4*)((const GAS bf16*)U + (size_t)tg * INW + cc * 8) : (u32x4){0u, 0u, 0u, 0u}; } } while (0)
    PL_LOAD(0);
    { const int wbase = (tid & 63) * SP + (tid >> 6);
#pragma unroll
      for (int i = 0; i < 32; ++i) WT[wbase + (i >> 3) * 64 * SP + 8 * (i & 7)] = (bf16)(pk2(((const GAS float*)poolw)[tid + 512 * i], 0.f) & 0xffffu); }
#pragma unroll 1
    for (int qq = 0; qq < 4; ++qq) {
#pragma unroll
        for (int i = 0; i < 5; ++i) { const int ch = tid + 512 * i, row = ch >> 5, cc = ch & 31; if (ch < 79 * 32) *(LAS u32x4*)(XT + row * PPP + cc * 8) = xr[i]; }
        if (qq + 1 < 4) PL_LOAD(qq + 1);
        __syncthreads();
        { const int g = w & 3, pair = lane & 31, run = (w >> 2) * 2 + (lane >> 5), tseq0 = (Rb + qq * 64 + run * 16) % SEQ;
          if (g == 0) pool_win<2>(XT, PP, run, tseq0, 0, pair); else if (g == 1) pool_win<4>(XT, PP, run, tseq0, 1, pair); else if (g == 2) pool_win<8>(XT, PP, run, tseq0, 2, pair); else pool_win<16>(XT, PP, run, tseq0, 3, pair); }
        __syncthreads();
        { const int tt = w & 3, gh = w >> 2;
#pragma unroll
          for (int gi = 0; gi < 2; ++gi) { const int g = 2 * gh + gi; bf16x8 pf[2];
#pragma unroll
            for (int kk = 0; kk < 2; ++kk) pf[kk] = *(const LAS bf16x8*)(PP + (16 * tt + fr) * PPP + g * 64 + kk * 32 + 8 * fq);
#pragma unroll
            for (int dt = 0; dt < 4; ++dt) { f32x4 acc = (f32x4){0.f, 0.f, 0.f, 0.f};
#pragma unroll
                for (int kk = 0; kk < 2; ++kk) { const bf16x8 wf = *(const LAS bf16x8*)(WT + (g * 64 + dt * 16 + fr) * SP + kk * 32 + 8 * fq); acc = MFMA16(wf, pf[kk], acc); }
                const int dcol = g * 64 + dt * 16 + 4 * fq; const f32x4 sc = *(const LAS f32x4*)(SCL + dcol);
                u32x2 o; o.x = pk2(acc[0] * sc[0], acc[1] * sc[1]); o.y = pk2(acc[2] * sc[2], acc[3] * sc[3]);
                *(GAS u32x2*)((GAS bf16*)Y + (size_t)(Rb + qq * 64 + 16 * tt + fr) * D + dcol) = o; } } }
        __syncthreads();
    }
#undef PL_LOAD
}

struct Args { const float* in[12]; float* out; unsigned char* ws; int ph_lo, ph_hi; };
static_assert(sizeof(Args) == 12 * 8 + 8 + 8 + 8, "Args has no padding");

__global__ void __launch_bounds__(NWAVES * 64, 2) mk_fwd(Args args) {
    extern __shared__ __attribute__((aligned(16))) unsigned char lds_raw[];
    LAS unsigned char* lds = (LAS unsigned char*)lds_raw;
    const int tid = threadIdx.x, lane = tid & 63, wave = __builtin_amdgcn_readfirstlane(tid >> 6);
    const int G = gridDim.x, bx = blockIdx.x, gw = bx * NWAVES + wave, ngw = G * NWAVES;
    unsigned char* ws = args.ws;
    float* X = args.out;
#define INPTRS(A) const float* norm_mix_g = (A).in[1]; const float* w_in = (A).in[2]; const float* pool_w = (A).in[3]; const float* pool_scale = (A).in[4]; \
    const float* hgrn_norm_g = (A).in[6]; const float* w_out = (A).in[7]; const float* norm_mlp_g = (A).in[8]; const float* w_up = (A).in[9]; const float* w_down = (A).in[10];
#define WSPTRS(wsb) bf16* WIN = (bf16*)((wsb) + WS_WIN); bf16* WIN2 = (bf16*)((wsb) + WS_WIN2); bf16* WOUT = (bf16*)((wsb) + WS_WOUT); bf16* WUP = (bf16*)((wsb) + WS_WUP); bf16* WDN = (bf16*)((wsb) + WS_WDN); \
    bf16* XB = (bf16*)((wsb) + WS_XB); bf16* Yb = (bf16*)((wsb) + WS_Y); bf16* U = (bf16*)((wsb) + WS_U); bf16* Hb = (bf16*)((wsb) + WS_U); \
    float* SEGS = (float*)((wsb) + WS_SEGS); float* SEGD = (float*)((wsb) + WS_SEGD); float* SS = (float*)((wsb) + WS_SS); float* LB = (float*)((wsb) + WS_LB);
    const int lo = args.ph_lo, hi = args.ph_hi;
#if MK_SINGLE
    volatile LAS unsigned* MISC = (volatile LAS unsigned*)(lds + MISC_OFF);
    if (tid < 32) MISC[tid] = 0u;
    __syncthreads();
    (void)xcd_barrier_post((unsigned*)(ws + WS_BAR), MISC);
#define SEAM(k) do { if ((k) + 1 < hi) { { XcdBarrier xb_; xb_.bar = (unsigned*)(args.ws + WS_BAR); xb_.x = xb_xcc_id(); xb_.st = (volatile LAS unsigned*)(lds + MISC_OFF); xcd_barrier(xb_); } } } while (0)
#else
#define SEAM(k) do { } while (0)
#endif
#define IN(k) (lo <= (k) && (k) < hi)

    if (IN(0)) {
        WSPTRS(ws)
        const float* x_in = args.in[0]; const float* norm_mix_g = args.in[1]; const float* w_in = args.in[2]; const float* lb_logits = args.in[5];
        if (bx == 0) for (int ch = tid; ch < HW; ch += NWAVES * 64) {
            float l0 = lb_logits[ch], l1 = lb_logits[HW + ch], l2 = lb_logits[2 * HW + ch], l3 = lb_logits[3 * HW + ch];
            const float mx = fmaxf(fmaxf(l0, l1), fmaxf(l2, l3)); l0 = expf(l0 - mx); l1 = expf(l1 - mx); l2 = expf(l2 - mx); l3 = expf(l3 - mx);
            const float inv = 1.0f / (l0 + l1 + l2 + l3);
            LB[ch] = 0.f; LB[HW + ch] = l1 * inv; LB[2 * HW + ch] = (l1 + l2) * inv; LB[3 * HW + ch] = (l1 + l2 + l3) * inv; }
        (void)convert_one(lds, w_in, norm_mix_g, WIN, D, INW, 0, gw, ngw, wave, lane);
        for (int m = gw; m < M; m += 2 * ngw) {
            const int m2 = m + ngw; const bool has2 = m2 < M;
            const f32x4* xr = (const f32x4*)(x_in + (size_t)m * D) + lane; const f32x4* xr2 = (const f32x4*)(x_in + (size_t)(has2 ? m2 : m) * D) + lane; f32x4 v[4], v2[4]; float s = 0.f, s2 = 0.f;
#pragma unroll
            for (int j = 0; j < 4; ++j) { v[j] = xr[64 * j]; v2[j] = xr2[64 * j]; }
#pragma unroll
            for (int j = 0; j < 4; ++j) { s += (v[j][0] * v[j][0] + v[j][1] * v[j][1]) + (v[j][2] * v[j][2] + v[j][3] * v[j][3]); s2 += (v2[j][0] * v2[j][0] + v2[j][1] * v2[j][1]) + (v2[j][2] * v2[j][2] + v2[j][3] * v2[j][3]); }
            s = wave_sum(s); s2 = wave_sum(s2);
            u32x2* bo = (u32x2*)(XB + (size_t)m * D) + lane; u32x2* bo2 = (u32x2*)(XB + (size_t)m2 * D) + lane;
#pragma unroll
            for (int j = 0; j < 4; ++j) { u32x2 o; o.x = pk2(v[j][0], v[j][1]); o.y = pk2(v[j][2], v[j][3]); bo[64 * j] = o; if (has2) { u32x2 o2; o2.x = pk2(v2[j][0], v2[j][1]); o2.y = pk2(v2[j][2], v2[j][3]); bo2[64 * j] = o2; } }
            if (lane < 16) { SS[(size_t)m * 16 + lane] = (lane == 0) ? s : 0.f; if (has2) SS[(size_t)m2 * 16 + lane] = (lane == 0) ? s2 : 0.f; }
        }
        SEAM(0);
    }
#pragma unroll 1
    for (int l = 0; l < DEPTH; ++l) {
        const int pb = 1 + 5 * l;
        int tid_l = threadIdx.x; asm volatile("" : "+v"(tid_l));
        unsigned char* ws_l = ws; asm volatile("" : "+s"(ws_l));
        const int lane_l = tid_l & 63, wave_l = __builtin_amdgcn_readfirstlane(tid_l >> 6), gw_l = bx * NWAVES + wave_l;
        WSPTRS(ws_l)
        const __attribute__((address_space(4))) Args* ap = (const __attribute__((address_space(4))) Args*)__builtin_amdgcn_kernarg_segment_ptr(); asm volatile("" : "+s"(ap));
        INPTRS(*ap)
        float* X = ap->out;
#pragma unroll 1
        for (int sub = 0; sub < 2; ++sub) {
            if (IN(pb + sub)) {
                int tid_s = threadIdx.x; asm volatile("" : "+v"(tid_s));
                const int lane_s = tid_s & 63, wave_s = __builtin_amdgcn_readfirstlane(tid_s >> 6);
                bf16* WINc = (l & 1) ? WIN2 : WIN;
                const bool pool_cu = bx >= NHITEMS && bx < NHITEMS + NPOOL;
                unsigned* pf = (unsigned*)(ws_l + WS_BAR + WS_PFLAG); const unsigned ep = (unsigned)(l + 1);
                if (sub == 1 && bx < NHITEMS) {
                    hgrn_item<false>(lds, U, Yb, SEGS, SEGD, hgrn_norm_g + l * HW, bx, tid_s);
                    asm volatile("s_waitcnt vmcnt(0)" ::: "memory");
                    __syncthreads();
                    if (tid_s == 0) __hip_atomic_store(pf + 64 * (64 + bx), ep, __ATOMIC_RELAXED, __HIP_MEMORY_SCOPE_AGENT);
                    if (tid_s < 64) { const int jseg = bx % NSEG, f0i = 64 + (bx / NSEG) * NSEG; const bool mine = lane_s < jseg; unsigned sp = 0;
                        for (;;) { const bool ok = !mine || __hip_atomic_load(pf + 64 * (f0i + lane_s), __ATOMIC_RELAXED, __HIP_MEMORY_SCOPE_AGENT) == ep;
                                   if (__ballot(!ok) == 0ull) break; __builtin_amdgcn_s_sleep(2); if (++sp > (1u << 20)) break; } }
                    if (tid_s == 0) { __builtin_amdgcn_fence(__ATOMIC_ACQUIRE, "agent"); asm volatile("s_waitcnt vmcnt(0)" ::: "memory"); }
                    __syncthreads();
                    hgrn_item<true>(lds, U, Yb, SEGS, SEGD, hgrn_norm_g + l * HW, bx, tid_s);
                }
                if (sub == 0 && (bx & 8)) {
                    const int cgw = ((bx >> 4) * 8 + (bx & 7)) * NWAVES + wave_s, cngw = (G / 2) * NWAVES;
                    int cb = convert_one(lds, w_out + (size_t)l * D * D, nullptr, WOUT, D, D, 0, cgw, cngw, wave_s, lane_s);
                    cb = convert_one(lds, w_up + (size_t)l * D * FF, norm_mlp_g + l * D, WUP, D, FF, cb, cgw, cngw, wave_s, lane_s);
                    __syncthreads();
                }
                if (sub == 0 || (sub == 1 && pool_cu)) {
                    pg8::Gemm g{XB, WINc, M, INW, D}; pg8::FlexOrder S; S.base.init(M, INW - PW, G, bx); S.pn0 = 1; S.single = sub; S.pm1 = bx - NHITEMS; S.pn1 = 0;
                    pg8::EpiAct E{U, INW, SS + (size_t)(2 * l) * M * 16, LB + l * HW, 1};
                    pg8::gemm_phase<pg8::EpiAct, pg8::FlexOrder, true, true>(lds, g, S, E);
                }
                if (sub == 1 && pool_cu) {
                    const int p = bx - NHITEMS;
                    asm volatile("s_waitcnt vmcnt(0)" ::: "memory");
                    __syncthreads();
                    if (tid_s == 0) __hip_atomic_store(pf + 64 * p, ep, __ATOMIC_RELAXED, __HIP_MEMORY_SCOPE_AGENT);
                    if ((p % (SEQ / 256)) != 0 && tid_s < 64) {
                        unsigned sp = 0; while (__hip_atomic_load(pf + 64 * (p - 1), __ATOMIC_RELAXED, __HIP_MEMORY_SCOPE_AGENT) != ep) { __builtin_amdgcn_s_sleep(2); if (++sp > (1u << 20)) break; } }
                    if (tid_s == 0) { __builtin_amdgcn_fence(__ATOMIC_ACQUIRE, "agent"); asm volatile("s_waitcnt vmcnt(0)" ::: "memory"); }
                    __syncthreads();
                    pool_item(lds, U, Yb, pool_w + (size_t)l * 16384, pool_scale + l * PW, p, tid_s);
                }
                SEAM(pb + sub);
            }
        }
        if (IN(pb + 2) ) {
            pg8::Gemm g{Yb, WOUT, M, D, D}; pg8::StaticOrder S; S.init(M, D, G, bx);
            pg8::EpiResid E{XB, SS + (size_t)(2 * l + 1) * M * 16};
            pg8::gemm_phase<pg8::EpiResid, pg8::StaticOrder, true, true>(lds, g, S, E);
            SEAM(pb + 2) ;
        }
        if (IN(pb + 3) ) {
            if (bx & 8) {
                int tid_c = threadIdx.x; asm volatile("" : "+v"(tid_c));
                const int lane_c = tid_c & 63, wave_c = __builtin_amdgcn_readfirstlane(tid_c >> 6);
                const int cgw = ((bx >> 4) * 8 + (bx & 7)) * NWAVES + wave_c, cngw = (G / 2) * NWAVES;
                int cb = convert_one(lds, w_down + (size_t)l * FF * D, nullptr, WDN, FF, D, 0, cgw, cngw, wave_c, lane_c);
                if (l + 1 < DEPTH) cb = convert_one(lds, w_in + (size_t)(l + 1) * D * INW, norm_mix_g + (l + 1) * D, ((l + 1) & 1) ? WIN2 : WIN, D, INW, cb, cgw, cngw, wave_c, lane_c);
                __syncthreads();
            }
            pg8::Gemm g{XB, WUP, M, FF, D}; pg8::StaticOrder S; S.init(M, FF, G, bx);
            pg8::EpiAct E{Hb, FF, SS + (size_t)(2 * l + 1) * M * 16, nullptr, 0};
            pg8::gemm_phase<pg8::EpiAct, pg8::StaticOrder, true, true>(lds, g, S, E);
            SEAM(pb + 3) ;
        }
        if (IN(pb + 4) ) {
            pg8::Gemm g{Hb, WDN, M, D, FF}; pg8::StaticOrder S; S.init(M, D, G, bx);
            pg8::EpiResid E{XB, SS + (size_t)(2 * l + 2) * M * 16};
            pg8::gemm_phase<pg8::EpiResid, pg8::StaticOrder, true, true>(lds, g, S, E);
            SEAM(pb + 4) ;
        }
    }
    if (IN(NPHASES - 1)) {
        int tid_f = threadIdx.x; asm volatile("" : "+v"(tid_f));
        const int lane_f = tid_f & 63, gw_f = bx * NWAVES + __builtin_amdgcn_readfirstlane(tid_f >> 6);
        const float* ssf = (const float*)(args.ws + WS_SS) + (size_t)(2 * DEPTH) * M * 16; float* Xf = args.out;
        for (int m = gw_f; m < M; m += 2 * ngw) {
            const int m2 = m + ngw; const bool has2 = m2 < M; const int mb = has2 ? m2 : m;
            const float q1 = lane_f < 16 ? ssf[(size_t)m * 16 + lane_f] : 0.f, q2 = lane_f < 16 ? ssf[(size_t)mb * 16 + lane_f] : 0.f;
            const u32x2* br = (const u32x2*)((const bf16*)(args.ws + WS_XB) + (size_t)m * D) + lane_f; const u32x2* br2 = (const u32x2*)((const bf16*)(args.ws + WS_XB) + (size_t)mb * D) + lane_f;
            u32x2 b1[4], b2[4];
#pragma unroll
            for (int j = 0; j < 4; ++j) { b1[j] = br[64 * j]; b2[j] = br2[64 * j]; }
            const float rs = rsqrtf(wave_sum(q1) * (1.0f / D) + EPS), rs2 = rsqrtf(wave_sum(q2) * (1.0f / D) + EPS);
            f32x4* xr = (f32x4*)(Xf + (size_t)m * D) + lane_f; f32x4* xr2 = (f32x4*)(Xf + (size_t)mb * D) + lane_f; const f32x4* gr = (const f32x4*)args.in[11] + lane_f;
#pragma unroll
            for (int j = 0; j < 4; ++j) { const f32x4 gv = gr[64 * j]; const f32x4 xv = (f32x4){bflo(b1[j].x), bfhi(b1[j].x), bflo(b1[j].y), bfhi(b1[j].y)}; xr[64 * j] = xv * rs * gv;
                if (has2) { const f32x4 xw = (f32x4){bflo(b2[j].x), bfhi(b2[j].x), bflo(b2[j].y), bfhi(b2[j].y)}; xr2[64 * j] = xw * rs2 * gv; } }
        }
    }
#undef IN
#undef SEAM
}

extern "C" void kernel_launch(void* const* d_in, const int* in_sizes, int n_in, void* d_out, int out_size, void* d_ws, size_t ws_size, hipStream_t stream) {
    static int grid = 0;
    if (grid == 0) {
        if (n_in != 12 || in_sizes[0] != M * D || out_size != M * D || ws_size < WS_END) { fprintf(stderr, "kernel_launch: unexpected shapes (n_in %d, in0 %d, out %d, ws %zu)\n", n_in, n_in > 0 ? in_sizes[0] : -1, out_size, ws_size); grid = -1; return; }
        int dev = 0, cus = 0, per_cu = 0;
        if (hipGetDevice(&dev) != hipSuccess || hipDeviceGetAttribute(&cus, hipDeviceAttributeMultiprocessorCount, dev) != hipSuccess) { grid = -1; return; }
        if (hipFuncSetAttribute((const void*)mk_fwd, hipFuncAttributeMaxDynamicSharedMemorySize, LDS_BYTES) != hipSuccess) { fprintf(stderr, "kernel_launch: hipFuncSetAttribute failed\n"); grid = -1; return; }
        if (hipOccupancyMaxActiveBlocksPerMultiprocessor(&per_cu, (const void*)mk_fwd, NWAVES * 64, LDS_BYTES) != hipSuccess || per_cu < 1) { fprintf(stderr, "kernel_launch: occupancy query says %d\n", per_cu); per_cu = 1; }
        (void)hipGetLastError();
        grid = cus * (per_cu < 1 ? 1 : per_cu);
        if (grid > 256) grid = 256;
        if (grid < NHITEMS + NPOOL) { fprintf(stderr, "kernel_launch: needs %d co-resident workgroups, have %d\n", NHITEMS + NPOOL, grid); grid = -1; return; }
    }
    if (grid < 0) return;
    (void)hipMemsetAsync((char*)d_ws + WS_BAR, 0, BAR_ZERO_BYTES, stream);
    Args a{};
    for (int i = 0; i < 12; ++i) a.in[i] = (const float*)d_in[i];
    a.out = (float*)d_out; a.ws = (unsigned char*)d_ws;
#if MK_SINGLE
    a.ph_lo = 0; a.ph_hi = NPHASES;
    void* kargs[] = {&a};
    hipError_t e = hipLaunchCooperativeKernel((const void*)mk_fwd, dim3(grid), dim3(NWAVES * 64), kargs, LDS_BYTES, stream);
    if (e != hipSuccess) fprintf(stderr, "kernel_launch: cooperative launch failed: %s (grid %d)\n", hipGetErrorString(e), grid);
#else
    for (int p = 0; p < NPHASES; ++p) { a.ph_lo = p; a.ph_hi = p + 1; hipLaunchKernelGGL(mk_fwd, dim3(grid), dim3(NWAVES * 64), LDS_BYTES, stream, a); }
#endif
}
```
